# Optimizing an MI355X kernel written in HIP

```python
import jax, jax.numpy as jnp
from jax import lax
import numpy as np

D_MODEL = 1024
BATCH = 4
SEQ = 8192
DEPTH = 1

CHUNK = 64
N_MEM = 256
MEM_HEADS = 4
MEM_HEAD_DIM = D_MODEL // MEM_HEADS
MIX_WIDTH = D_MODEL
HG_WIDTH = MIX_WIDTH // 2
HG_HEADS = 4
HG_HEAD_DIM = HG_WIDTH // HG_HEADS
SB_WIDTH = MIX_WIDTH - HG_WIDTH
SB_HEADS = 8
SB_HEAD_DIM = SB_WIDTH // SB_HEADS
SB_BLOCK = 128
D_FF = 2816
IN_COLS = 4 * HG_WIDTH + 3 * SB_WIDTH
EPS = 1e-6

kernel_name = "hybrid_hgrn2_stickbreaking_macaron_layer"


def rmsnorm(x, g):
    xf = x.astype(jnp.float32)
    y = xf * lax.rsqrt(jnp.mean(xf * xf, axis=-1, keepdims=True) + EPS)
    return (y * g.astype(jnp.float32)).astype(x.dtype)


def head_rmsnorm(o, g):
    B, S, H, d = o.shape
    of = o.astype(jnp.float32)
    y = of * lax.rsqrt(jnp.mean(of * of, axis=-1, keepdims=True) + EPS)
    return y * g.astype(jnp.float32).reshape(H, d)


def swiglu(h, w_gu, w_down):
    gu = h @ w_gu
    gate, up = jnp.split(gu, 2, axis=-1)
    return (jax.nn.silu(gate) * up) @ w_down


def hgrn2_mixer(q, f_logit, i, g, lb, gnorm):
    B, S, _ = q.shape
    n_chunks = S // CHUNK
    lbf = lb.astype(jnp.float32)
    f = lbf + (1.0 - lbf) * jax.nn.sigmoid(f_logit.astype(jnp.float32))
    k = 1.0 - f
    logf = jnp.log(f)

    def to_chunks(t):
        return t.astype(jnp.float32).reshape(B, n_chunks, CHUNK, HG_HEADS, HG_HEAD_DIM).transpose(1, 0, 3, 2, 4)

    qc, kc, vc = to_chunks(q), to_chunks(k), to_chunks(i)
    bc = jnp.cumsum(to_chunks(logf), axis=3)
    causal = jnp.tril(jnp.ones((CHUNK, CHUNK), dtype=bool))[None, None, :, :, None]

    def step(state, inp):
        qt, kt, vt, bt = inp
        diff = bt[:, :, :, None, :] - bt[:, :, None, :, :]
        decay = jnp.exp(jnp.where(causal, diff, -jnp.inf))
        a = jnp.einsum('bhtd,bhsd,bhtsd->bhts', qt, kt, decay)
        o_intra = jnp.einsum('bhts,bhsv->bhtv', a, vt)
        o_inter = jnp.einsum('bhtd,bhdv->bhtv', qt * jnp.exp(bt), state)
        b_last = bt[:, :, -1:, :]
        k_dec = kt * jnp.exp(b_last - bt)
        new_state = jnp.exp(b_last[:, :, 0, :])[..., None] * state + jnp.einsum('bhsd,bhsv->bhdv', k_dec, vt)
        return new_state, o_intra + o_inter

    s0 = jnp.zeros((B, HG_HEADS, HG_HEAD_DIM, HG_HEAD_DIM), jnp.float32)
    _, o = lax.scan(step, s0, (qc, kc, vc, bc))
    o = o.transpose(1, 0, 3, 2, 4).reshape(B, S, HG_HEADS, HG_HEAD_DIM)
    o = head_rmsnorm(o, gnorm).reshape(B, S, HG_WIDTH)
    return o * jax.nn.silu(g.astype(jnp.float32))


def stick_breaking_mixer(q, k, v, gnorm):
    B, S, _ = q.shape
    n_blk = S // SB_BLOCK
    scale = SB_HEAD_DIM ** -0.5

    def heads(t):
        return t.astype(jnp.float32).reshape(B, S, SB_HEADS, SB_HEAD_DIM).transpose(0, 2, 1, 3)

    qh, kh, vh = heads(q), heads(k), heads(v)
    qb = qh.reshape(B, SB_HEADS, n_blk, SB_BLOCK, SB_HEAD_DIM).transpose(2, 0, 1, 3, 4)
    key_pos = jnp.arange(S)

    def block(args):
        q_blk, blk = args
        z = jnp.einsum('bhtd,bhsd->bhts', q_blk, kh) * scale
        q_pos = blk * SB_BLOCK + jnp.arange(SB_BLOCK)
        before = (key_pos[None, :] < q_pos[:, None])[None, None]
        log_beta = jax.nn.log_sigmoid(z)
        log_one_minus = jnp.where(before, jax.nn.log_sigmoid(-z), 0.0)
        between = lax.cumsum(log_one_minus, axis=3, reverse=True) - log_one_minus
        weights = jnp.exp(jnp.where(before, log_beta + between, -jnp.inf))
        return jnp.einsum('bhts,bhsd->bhtd', weights, vh)

    o = lax.map(block, (qb, jnp.arange(n_blk)))
    o = o.transpose(1, 0, 3, 2, 4).reshape(B, S, SB_HEADS, SB_HEAD_DIM)
    return head_rmsnorm(o, gnorm).reshape(B, S, SB_WIDTH)


def memory_cross_attention(h, m, w_q, w_kv, w_o):
    B, S, _ = h.shape
    q = (h @ w_q).reshape(B, S, MEM_HEADS, MEM_HEAD_DIM)
    k, v = jnp.split(m @ w_kv, 2, axis=-1)
    k = k.reshape(B, N_MEM, MEM_HEADS, MEM_HEAD_DIM)
    v = v.reshape(B, N_MEM, MEM_HEADS, MEM_HEAD_DIM)
    s = jnp.einsum('bthd,bnhd->bhtn', q, k).astype(jnp.float32) * (MEM_HEAD_DIM ** -0.5)
    p = jax.nn.softmax(s, axis=-1).astype(h.dtype)
    o = jnp.einsum('bhtn,bnhd->bthd', p, v).reshape(B, S, D_MODEL)
    return o @ w_o


def setup_inputs(seed: int = 0) -> dict:
    key = jax.random.key(seed)
    ks = jax.random.split(key, 24)
    f32 = jnp.float32

    def w(k, shape, fan_in, gain=1.0):
        return (jax.random.normal(k, shape, f32) * (gain * fan_in ** -0.5)).astype(f32)

    def norm_gain(k, shape):
        return (1.0 + 0.02 * jax.random.normal(k, shape, f32)).astype(f32)

    return {
        "x": jax.random.normal(ks[0], (BATCH, SEQ, D_MODEL), f32),
        "mem": jax.random.normal(ks[1], (BATCH, N_MEM, D_MODEL), f32),
        "ffn1_norm": norm_gain(ks[2], (DEPTH, D_MODEL)),
        "ffn1_w_gu": w(ks[3], (DEPTH, D_MODEL, 2 * D_FF), D_MODEL),
        "ffn1_w_down": w(ks[4], (DEPTH, D_FF, D_MODEL), D_FF),
        "mix_norm": norm_gain(ks[5], (DEPTH, D_MODEL)),
        "w_in": w(ks[6], (DEPTH, D_MODEL, IN_COLS), D_MODEL),
        "hg_lb_raw": (0.5 * jax.random.normal(ks[7], (DEPTH + 1, HG_WIDTH), f32)).astype(f32),
        "hg_gnorm": norm_gain(ks[8], (DEPTH, HG_WIDTH)),
        "sb_gnorm": norm_gain(ks[9], (DEPTH, SB_WIDTH)),
        "w_out": w(ks[10], (DEPTH, MIX_WIDTH, D_MODEL), MIX_WIDTH),
        "mem_q_norm": norm_gain(ks[11], (DEPTH, D_MODEL)),
        "mem_kv_norm": norm_gain(ks[12], (DEPTH, D_MODEL)),
        "mem_w_q": w(ks[13], (DEPTH, D_MODEL, D_MODEL), D_MODEL),
        "mem_w_kv": w(ks[14], (DEPTH, D_MODEL, 2 * D_MODEL), D_MODEL),
        "mem_w_o": w(ks[15], (DEPTH, D_MODEL, D_MODEL), D_MODEL),
        "ffn2_norm": norm_gain(ks[16], (DEPTH, D_MODEL)),
        "ffn2_w_gu": w(ks[17], (DEPTH, D_MODEL, 2 * D_FF), D_MODEL),
        "ffn2_w_down": w(ks[18], (DEPTH, D_FF, D_MODEL), D_FF),
        "final_norm": norm_gain(ks[19], (D_MODEL,)),
    }


def reference(x, mem, ffn1_norm, ffn1_w_gu, ffn1_w_down, mix_norm, w_in, hg_lb_raw,
              hg_gnorm, sb_gnorm, w_out, mem_q_norm, mem_kv_norm, mem_w_q, mem_w_kv,
              mem_w_o, ffn2_norm, ffn2_w_gu, ffn2_w_down, final_norm):
    lb_all = jnp.cumsum(jax.nn.softmax(hg_lb_raw.astype(jnp.float32), axis=0), axis=0)
    for l in range(DEPTH):
        x = x + 0.5 * swiglu(rmsnorm(x, ffn1_norm[l]), ffn1_w_gu[l], ffn1_w_down[l])

        h = rmsnorm(x, mix_norm[l])
        proj = h @ w_in[l]
        hg_q, hg_f, hg_i, hg_g, sb_q, sb_k, sb_v = jnp.split(
            proj, np.cumsum([HG_WIDTH] * 4 + [SB_WIDTH] * 2).tolist(), axis=-1)
        o_hg = hgrn2_mixer(hg_q, hg_f, hg_i, hg_g, lb_all[l], hg_gnorm[l])
        o_sb = stick_breaking_mixer(sb_q, sb_k, sb_v, sb_gnorm[l])
        mixed = jnp.concatenate([o_hg, o_sb], axis=-1).astype(x.dtype)
        x = x + mixed @ w_out[l]

        x = x + memory_cross_attention(rmsnorm(x, mem_q_norm[l]), rmsnorm(mem, mem_kv_norm[l]),
                                       mem_w_q[l], mem_w_kv[l], mem_w_o[l])

        x = x + 0.5 * swiglu(rmsnorm(x, ffn2_norm[l]), ffn2_w_gu[l], ffn2_w_down[l])
    return rmsnorm(x, final_norm)
```

```cpp
#include <hip/hip_runtime.h>
#include <cstdio>
#include <cstdint>

#ifndef MK_ONE_LAUNCH
#define MK_ONE_LAUNCH 0
#endif

namespace pg8 {
#define PG8_LAS __attribute__((address_space(3)))
typedef unsigned short bf16_t;
typedef short bf16x8 __attribute__((ext_vector_type(8)));
typedef float f32x4 __attribute__((ext_vector_type(4)));
typedef float f32x2 __attribute__((ext_vector_type(2)));
typedef unsigned u32x4 __attribute__((ext_vector_type(4)));
constexpr int BM = 256, BK = 64, HALF = 128, HTB = HALF * BK * 2, STAGE_BYTES = 8 * HTB, NXCD = 8, WGM = 8;

__host__ __device__ __forceinline__ int lds_byte(int r, int c) { const int st = (r >> 4) * 2 + (c >> 5), rr = r & 15, cc = c & 31, ob = rr * 64 + cc * 2; return st * 1024 + (ob ^ (((ob >> 9) & 1) << 5)); }
__host__ __device__ __forceinline__ void stage_rc(int b, int& R, int& C) { const int st = b / 1024, sb = b % 1024, swz = sb ^ (((sb >> 9) & 1) << 5); R = (st >> 1) * 16 + swz / 64; C = (st & 1) * 32 + (swz % 64) / 2; }
__host__ __device__ __forceinline__ int perm32(int rho) { const int n = rho >> 4, i = rho & 15; return 8 * (i >> 2) + 4 * n + (i & 3); }

struct Unit { int pm, pn; const char* a; const char* b; };

__device__ __forceinline__ unsigned cvt_pk_bf16(float lo, float hi) { unsigned r; asm volatile("v_cvt_pk_bf16_f32 %0, %1, %2" : "=v"(r) : "v"(lo), "v"(hi)); return r; }

struct TileOrder {
    const char* A; const char* B; int lda, ldb; int nM, nN, nwg, G, c;
    __device__ __forceinline__ void init(const void* A_, const void* B_, int lda_, int ldb_, int M, int N, int G_, int c_) { A = (const char*)A_; B = (const char*)B_; lda = lda_; ldb = ldb_; nM = M / BM; nN = N / BM; nwg = nM * nN; G = G_; c = c_; }
    __device__ __forceinline__ bool next(int i, Unit& u) const {
        const long L = (long)i * G + c; if (L >= nwg) return false;
        int wgid = (int)L; { const int q = nwg / NXCD, r = nwg % NXCD, xcd = wgid % NXCD, off = wgid / NXCD; wgid = (xcd < r ? xcd * (q + 1) : r * (q + 1) + (xcd - r) * q) + off; }
        const int nig = WGM * nN, gid = wgid / nig, fm = gid * WGM, gsz = (nM - fm) < WGM ? (nM - fm) : WGM;
        u.pm = fm + ((wgid % nig) % gsz); u.pn = (wgid % nig) / gsz;
        u.a = A + (size_t)u.pm * BM * lda * 2; u.b = B + (size_t)u.pn * BM * ldb * 2; return true;
    }
};

template <class Epi, class Sched>
__device__ __forceinline__ void gemm_phase(PG8_LAS unsigned char* lds, const int K, const int lda, const int ldb, const Sched& S, const Epi& E) {
    const int tid = threadIdx.x, wid = __builtin_amdgcn_readfirstlane(tid >> 6), lane = tid & 63, wr = wid >> 2, wc = wid & 3, fr = lane & 15, fq = lane >> 4;
    const int nt = K / BK;
    unsigned voffA[2], voffB[2];
#pragma unroll
    for (int i = 0; i < 2; ++i) { int R, C; stage_rc(tid * 16 + i * 8192, R, C); const int Rb = Epi::PERM ? ((R & ~31) + perm32(R & 31)) : R;
        voffA[i] = (unsigned)(R * lda + C) * 2u; voffB[i] = (unsigned)(Rb * ldb + C) * 2u; }
    const size_t kstep = (size_t)(BK * 2);
    const size_t hstepA = (size_t)HALF * lda * 2, hstepB = (size_t)HALF * ldb * 2;
    const unsigned ldsw = (unsigned)wid * 1024u;
    const int aoff = lds_byte(wr * 64 + fr, fq * 8), boff = lds_byte(wc * 32 + fr, fq * 8);
#define PG8_SA(b, h) (((b) * 2 + (h)) * HTB)
#define PG8_SB(b, h) ((4 + (b) * 2 + (h)) * HTB)
#define PG8_STAGE(bufoff, gbase, voff) do { _Pragma("unroll") for (int _i = 0; _i < 2; ++_i) \
        __builtin_amdgcn_global_load_lds((const unsigned*)((const char*)(gbase) + (voff)[_i]), (PG8_LAS unsigned*)(lds + (bufoff) + ldsw + _i * 8192), 16, 0, 0); } while (0)
#define PG8_LDA(dst, b, h) do { _Pragma("unroll") for (int m = 0; m < 4; ++m) _Pragma("unroll") for (int k = 0; k < 2; ++k) dst[m][k] = *(const PG8_LAS bf16x8*)(lds + PG8_SA(b, h) + aoff + m * 2048 + k * 1024); } while (0)
#define PG8_LDB(dst, b, h) do { _Pragma("unroll") for (int n = 0; n < 2; ++n) _Pragma("unroll") for (int k = 0; k < 2; ++k) dst[n][k] = *(const PG8_LAS bf16x8*)(lds + PG8_SB(b, h) + boff + n * 2048 + k * 1024); } while (0)
#define PG8_MMA(ai, bj, At, Bt) do { __builtin_amdgcn_s_setprio(1); _Pragma("unroll") for (int m = 0; m < 4; ++m) _Pragma("unroll") for (int n = 0; n < 2; ++n) _Pragma("unroll") for (int k = 0; k < 2; ++k) \
        acc[ai][bj][m][n] = __builtin_amdgcn_mfma_f32_16x16x32_bf16(Bt[n][k], At[m][k], acc[ai][bj][m][n], 0, 0, 0); __builtin_amdgcn_s_setprio(0); } while (0)
#define PG8_WAIT_V(n) asm volatile("s_waitcnt vmcnt(" #n ")" ::: "memory")
#define PG8_WAIT_L(n) asm volatile("s_waitcnt lgkmcnt(" #n ")" ::: "memory")
#define PG8_BAR __builtin_amdgcn_s_barrier()
#define PG8_SCHED __builtin_amdgcn_sched_barrier(0)
    Unit cur, nxt; int ui = 0;
    if (!S.next(0, cur)) return;
    f32x4 acc[2][2][4][2];
#pragma unroll
    for (int a = 0; a < 2; ++a)
#pragma unroll
        for (int b = 0; b < 2; ++b)
#pragma unroll
            for (int m = 0; m < 4; ++m)
#pragma unroll
                for (int n = 0; n < 2; ++n) acc[a][b][m][n] = (f32x4){0.f, 0.f, 0.f, 0.f};
    bf16x8 At[4][2], B0[2][2], B1[2][2];
    const char* cA = cur.a; const char* cB = cur.b;
    PG8_STAGE(PG8_SB(0, 0), cB, voffB); PG8_STAGE(PG8_SB(0, 1), cB + hstepB, voffB); PG8_STAGE(PG8_SA(0, 0), cA, voffA); PG8_STAGE(PG8_SA(0, 1), cA + hstepA, voffA);
    if (wr == 1) PG8_BAR;
    PG8_WAIT_V(2); PG8_BAR;
    PG8_STAGE(PG8_SB(1, 0), cB + kstep, voffB); PG8_STAGE(PG8_SA(1, 0), cA + kstep, voffA); PG8_STAGE(PG8_SB(1, 1), cB + hstepB + kstep, voffB);
    PG8_WAIT_V(6); PG8_BAR;
    for (;;) {
        const bool has_next = S.next(ui + 1, nxt);
        const char* nA = has_next ? nxt.a : cA; const char* nB = has_next ? nxt.b : cB;
        for (int t = 0; t < nt; t += 2) {
            const bool last = (t == nt - 2);
            const char* a1 = cA + (size_t)(t + 1) * kstep;
            const char* a2 = last ? nA : cA + (size_t)(t + 2) * kstep; const char* b2 = last ? nB : cB + (size_t)(t + 2) * kstep;
            const char* a3 = a2 + kstep; const char* b3 = b2 + kstep;
            PG8_LDB(B0, 0, 0); PG8_LDB(B1, 0, 1); PG8_SCHED; PG8_LDA(At, 0, 0); PG8_STAGE(PG8_SA(1, 1), a1 + hstepA, voffA);
            PG8_WAIT_V(8); PG8_WAIT_L(0); PG8_BAR; PG8_MMA(0, 0, At, B0); PG8_MMA(0, 1, At, B1); PG8_BAR; PG8_SCHED;
            PG8_LDA(At, 0, 1); PG8_STAGE(PG8_SB(0, 0), b2, voffB); PG8_STAGE(PG8_SB(0, 1), b2 + hstepB, voffB); PG8_STAGE(PG8_SA(0, 0), a2, voffA);
            PG8_WAIT_V(8); PG8_WAIT_L(0); PG8_BAR; PG8_MMA(1, 0, At, B0); PG8_MMA(1, 1, At, B1); PG8_BAR; PG8_SCHED;
            PG8_LDB(B0, 1, 0); PG8_LDB(B1, 1, 1); PG8_SCHED; PG8_LDA(At, 1, 0); PG8_STAGE(PG8_SA(0, 1), a2 + hstepA, voffA);
            PG8_WAIT_V(8); PG8_WAIT_L(0); PG8_BAR; PG8_MMA(0, 0, At, B0); PG8_MMA(0, 1, At, B1); PG8_BAR; PG8_SCHED;
            PG8_LDA(At, 1, 1); PG8_STAGE(PG8_SB(1, 0), b3, voffB); PG8_STAGE(PG8_SB(1, 1), b3 + hstepB, voffB); PG8_STAGE(PG8_SA(1, 0), a3, voffA);
            PG8_WAIT_V(8); PG8_WAIT_L(0); PG8_BAR; PG8_MMA(1, 0, At, B0); PG8_MMA(1, 1, At, B1); PG8_BAR; PG8_SCHED;
        }
        if (wr == 0) PG8_BAR;
        E(acc, cur, wr, wc, fr, fq, wid, lane);
        if (!has_next) break;
#pragma unroll
        for (int a = 0; a < 2; ++a)
#pragma unroll
            for (int b = 0; b < 2; ++b)
#pragma unroll
                for (int m = 0; m < 4; ++m)
#pragma unroll
                    for (int n = 0; n < 2; ++n) acc[a][b][m][n] = (f32x4){0.f, 0.f, 0.f, 0.f};
        cur = nxt; cA = nA; cB = nB; ++ui;
        if (wr == 1) PG8_BAR;
    }
    PG8_WAIT_V(0);
    PG8_BAR;
#undef PG8_SA
#undef PG8_SB
#undef PG8_STAGE
#undef PG8_LDA
#undef PG8_LDB
#undef PG8_MMA
#undef PG8_WAIT_V
#undef PG8_WAIT_L
#undef PG8_BAR
#undef PG8_SCHED
}
}

constexpr int NWAVES = 8;
constexpr int BATCH = 4, SEQ = 8192, D = 1024, M = BATCH * SEQ;
constexpr int FF = 2816, GU = 2 * FF, INC = 3584, NMEM = 256, MROWS = BATCH * NMEM;
constexpr int HGW = 512, HGH = 4, HGD = 128, SBW = 512, SBH = 8, SBD = 64, CHD = 256;
constexpr float EPS = 1e-6f, LOG2E = 1.4426950408889634f, LN2 = 0.6931471805599453f;
constexpr float SB_QSCALE = 0.125f * LOG2E;
constexpr float CA_QSCALE = 0.0625f * LOG2E;
constexpr float SB_STOP = 160.0f;

constexpr size_t MiB = 1u << 20;
constexpr size_t WS_CTL = 0, CTL_ZERO_BYTES = 2 * MiB;
constexpr size_t WS_SS = 1 * MiB;
constexpr size_t WS_WGU1 = 2 * MiB, WS_WD1 = 13 * MiB, WS_WIN = 19 * MiB, WS_WOUT = 26 * MiB, WS_WQ = 28 * MiB, WS_WKV = 30 * MiB, WS_WO = 34 * MiB, WS_WGU2 = 36 * MiB, WS_WD2 = 47 * MiB;
constexpr size_t WS_MN = 53 * MiB, WS_KMEM = 55 * MiB, WS_VT = 57 * MiB;
constexpr size_t WS_XB = 64 * MiB;
constexpr size_t WS_HMID = 128 * MiB;
constexpr size_t WS_HQ = 128 * MiB, WS_LOGF = 160 * MiB, WS_HI = 224 * MiB, WS_HSG = 256 * MiB;
constexpr size_t WS_SBQ = 304 * MiB, WS_SBK = 336 * MiB, WS_SBV = 368 * MiB;
constexpr size_t WS_MIXED = 400 * MiB;
constexpr size_t WS_QC = 128 * MiB, WS_PM = 192 * MiB, WS_OC = 304 * MiB;
constexpr size_t WS_END = 464 * MiB;
constexpr int CW_TMO = 0, CW_CODE = 1, CW_BAR = 4096;

constexpr int RING_BYTES = 131072;
constexpr int LDSCTL_OFF = RING_BYTES, MISC_OFF = LDSCTL_OFF + 320;
constexpr int EPI_OFF = RING_BYTES + 1024;
constexpr int LDS_BYTES = 147456;

#define GAS __attribute__((address_space(1)))
#define LAS __attribute__((address_space(3)))
typedef unsigned short bf16;
typedef unsigned v4u __attribute__((ext_vector_type(4)));
typedef float f32x4 __attribute__((ext_vector_type(4)));
typedef GAS unsigned gu32;
#define RLX_AGENT __ATOMIC_RELAXED, __HIP_MEMORY_SCOPE_AGENT
#define LDS_WAIT() asm volatile("s_waitcnt lgkmcnt(0)" ::: "memory")
#define VM_WAIT() asm volatile("s_waitcnt vmcnt(0)" ::: "memory")
__device__ __forceinline__ unsigned f2bf(float f) { unsigned u = __builtin_bit_cast(unsigned, f); return (u + 0x7fffu + ((u >> 16) & 1u)) >> 16; }
__device__ __forceinline__ unsigned pk2(float lo, float hi) { return f2bf(lo) | (f2bf(hi) << 16); }
__device__ __forceinline__ float bf_lo(unsigned w) { return __builtin_bit_cast(float, w << 16); }
__device__ __forceinline__ float bf_hi(unsigned w) { return __builtin_bit_cast(float, w & 0xffff0000u); }
__device__ __forceinline__ float bf2f(bf16 h) { return __builtin_bit_cast(float, (unsigned)h << 16); }
__device__ __forceinline__ float ex2(float x) { return __builtin_amdgcn_exp2f(x); }
__device__ __forceinline__ float lg2(float x) { return __builtin_amdgcn_logf(x); }
__device__ __forceinline__ float rcpf_(float x) { return __builtin_amdgcn_rcpf(x); }
__device__ __forceinline__ float sigmoidf_(float v) { return rcpf_(1.0f + ex2(-v * LOG2E)); }
__device__ __forceinline__ float siluf_(float v) { return v * sigmoidf_(v); }
__device__ __forceinline__ float rdlane(float v, int l) { return __builtin_bit_cast(float, __builtin_amdgcn_readlane(__builtin_bit_cast(int, v), l)); }
__device__ __forceinline__ float wave_sum(float v) {
#pragma unroll
    for (int o = 1; o < 64; o <<= 1) v += __shfl_xor(v, o);
    return v;
}

#define XB_TMO      128
#define XB_XCNT(j)  (256  + 64 * (j))
#define XB_XSUB(j)  (1280 + 64 * (j))
#define XB_XGEN(j)  (2304 + 64 * (j))
#define XB_TOP      3328
#define XB_TOPGEN   3392
#define XCD_BAR_WORDS 3456
#define XB_SPIN_CAP (1u << 18)
__device__ __forceinline__ unsigned xb_ld(unsigned* p)              { return __hip_atomic_load(p, __ATOMIC_RELAXED, __HIP_MEMORY_SCOPE_AGENT); }
__device__ __forceinline__ unsigned xb_add(unsigned* p, unsigned v) { return __hip_atomic_fetch_add(p, v, __ATOMIC_RELAXED, __HIP_MEMORY_SCOPE_AGENT); }
__device__ __forceinline__ unsigned xb_xcc_id() { return (unsigned)__builtin_amdgcn_s_getreg((3 << 11) | 20) & 0xFu; }
#define XB_SPIN(cond, bar) do { unsigned _sp = 0; while (cond) { __builtin_amdgcn_s_sleep(1); \
    if ((++_sp & 255u) == 0u) { if (xb_ld(&(bar)[XB_TMO])) break; if (_sp > XB_SPIN_CAP) { atomicAdd(&(bar)[XB_TMO], 1u); break; } } } } while (0)
struct XcdBarrier { unsigned* bar; unsigned x; volatile LAS unsigned* st; };
__device__ __forceinline__ XcdBarrier xcd_barrier_post(unsigned* bar, volatile LAS unsigned* st) {
    XcdBarrier b; b.bar = bar; b.x = xb_xcc_id(); b.st = st;
    if (threadIdx.x == 0) (void)xb_add(&bar[XB_XCNT(b.x)], 1u);
    return b;
}
__device__ __forceinline__ void xcd_barrier_complete(unsigned* bar, unsigned x, unsigned& nloc, unsigned& nx) {
    const unsigned G = gridDim.x * gridDim.y * gridDim.z;
    unsigned sum, cnt, mine, sp = 0u;
    for (;;) {
        sum = 0u; cnt = 0u; mine = 0u;
#pragma unroll
        for (unsigned j = 0; j < 16; ++j) { const unsigned c = xb_ld(&bar[XB_XCNT(j)]); sum += c; cnt += (c > 0u) ? 1u : 0u; mine = (j == x) ? c : mine; }
        if (sum == G) break;
        __builtin_amdgcn_s_sleep(1);
        if ((++sp & 255u) == 0u) { if (xb_ld(&bar[XB_TMO])) break; if (sp > XB_SPIN_CAP) { atomicAdd(&bar[XB_TMO], 1u); break; } }
    }
    nloc = mine > 0u ? mine : 1u; nx = cnt > 0u ? cnt : 1u;
}
__device__ __forceinline__ void xcd_barrier(const XcdBarrier& b) {
    asm volatile("s_waitcnt vmcnt(0)" ::: "memory");
    __syncthreads();
    if (threadIdx.x == 0) {
        unsigned* bar = b.bar;
        __builtin_amdgcn_s_waitcnt(0);
        unsigned nloc = b.st[0], nx = b.st[1];
        if (nloc == 0u) { xcd_barrier_complete(bar, b.x, nloc, nx); b.st[0] = nloc; b.st[1] = nx; }
        const unsigned old = xb_add(&bar[XB_XSUB(b.x)], 1u);
        const unsigned gen = old / nloc;
        if (old + 1u == (gen + 1u) * nloc) {
            __builtin_amdgcn_fence(__ATOMIC_RELEASE, "agent");
            asm volatile("s_waitcnt vmcnt(0)" ::: "memory");
            const unsigned og = xb_add(&bar[XB_TOP], 1u);
            const unsigned tg = og / nx;
            if (og + 1u == (tg + 1u) * nx) xb_add(&bar[XB_TOPGEN], 1u);
            else XB_SPIN(xb_ld(&bar[XB_TOPGEN]) == tg, bar);
            __builtin_amdgcn_fence(__ATOMIC_ACQUIRE, "agent");
            xb_add(&bar[XB_XGEN(b.x)], 1u);
            asm volatile("s_waitcnt vmcnt(0)" ::: "memory");
        } else {
            XB_SPIN(xb_ld(&bar[XB_XGEN(b.x)]) == gen, bar);
            __builtin_amdgcn_fence(__ATOMIC_ACQUIRE, "agent");
            asm volatile("s_waitcnt vmcnt(0)" ::: "memory");
        }
    }
    __syncthreads();
}

using pg8::f32x4; using pg8::u32x4; using pg8::Unit; using pg8::cvt_pk_bf16;
typedef f32x4 acc_t[2][2][4][2];
__device__ __forceinline__ float rs_of(const float* ss, int row) { return __builtin_amdgcn_rsqf(ss[row] * (1.0f / (float)D) + EPS); }
__device__ __forceinline__ u32x4 pack8(const f32x4 a, const f32x4 b) { u32x4 w; w.x = cvt_pk_bf16(a[0], a[1]); w.y = cvt_pk_bf16(a[2], a[3]); w.z = cvt_pk_bf16(b[0], b[1]); w.w = cvt_pk_bf16(b[2], b[3]); return w; }

struct EpiSwiglu {
    static constexpr bool PERM = true;
    bf16* H; const float* ss;
    __device__ __forceinline__ void operator()(acc_t& acc, const Unit& u, int wr, int wc, int fr, int fq, int, int) const {
        const int row0 = u.pm * 256 + wr * 64 + fr, col0 = u.pn * 128 + wc * 32 + 8 * fq;
#pragma unroll
        for (int ai = 0; ai < 2; ++ai)
#pragma unroll
            for (int m = 0; m < 4; ++m) { const int row = row0 + ai * 128 + m * 16; const float r = rs_of(ss, row);
                f32x4 h[2];
#pragma unroll
                for (int n = 0; n < 2; ++n) { const f32x4 g = acc[ai][0][m][n] * r, up = acc[ai][1][m][n] * r;
#pragma unroll
                    for (int e = 0; e < 4; ++e) h[n][e] = siluf_(g[e]) * up[e]; }
                *(u32x4*)(H + (size_t)row * FF + col0) = pack8(h[0], h[1]); }
    }
};
struct EpiResid {
    static constexpr bool PERM = true;
    const float* xin; float* xout; bf16* xb; float* ssout; float alpha;
    __device__ __forceinline__ void operator()(acc_t& acc, const Unit& u, int wr, int wc, int fr, int fq, int, int) const {
        const int row0 = u.pm * 256 + wr * 64 + fr, col0 = u.pn * 256 + wc * 32 + 8 * fq;
#pragma unroll
        for (int ai = 0; ai < 2; ++ai)
#pragma unroll
            for (int m = 0; m < 4; ++m) { const int row = row0 + ai * 128 + m * 16; float part = 0.f;
#pragma unroll
                for (int bj = 0; bj < 2; ++bj) { const size_t off = (size_t)row * D + col0 + bj * 128;
                    const f32x4 a0 = *(const f32x4*)(xin + off), a1 = *(const f32x4*)(xin + off + 4);
                    const f32x4 o0 = a0 + acc[ai][bj][m][0] * alpha, o1 = a1 + acc[ai][bj][m][1] * alpha;
                    *(f32x4*)(xout + off) = o0; *(f32x4*)(xout + off + 4) = o1;
                    *(u32x4*)(xb + off) = pack8(o0, o1);
                    part += (o0[0] * o0[0] + o0[1] * o0[1]) + (o0[2] * o0[2] + o0[3] * o0[3]) + (o1[0] * o1[0] + o1[1] * o1[1]) + (o1[2] * o1[2] + o1[3] * o1[3]); }
                part += __shfl_xor(part, 16); part += __shfl_xor(part, 32);
                if (ssout && fq == 0) atomicAdd(ssout + row, part); }
    }
};
struct EpiPlain {
    static constexpr bool PERM = true;
    bf16* O; int ldc; const float* ss; float cs;
    __device__ __forceinline__ void operator()(acc_t& acc, const Unit& u, int wr, int wc, int fr, int fq, int, int) const {
        const int row0 = u.pm * 256 + wr * 64 + fr, col0 = u.pn * 256 + wc * 32 + 8 * fq;
#pragma unroll
        for (int ai = 0; ai < 2; ++ai)
#pragma unroll
            for (int m = 0; m < 4; ++m) { const int row = row0 + ai * 128 + m * 16; const float r = (ss ? rs_of(ss, row) : 1.0f) * cs;
#pragma unroll
                for (int bj = 0; bj < 2; ++bj) *(u32x4*)(O + (size_t)row * ldc + col0 + bj * 128) = pack8(acc[ai][bj][m][0] * r, acc[ai][bj][m][1] * r); }
    }
};
struct EpiWin {
    static constexpr bool PERM = true;
    const float* ss; const float* lbraw; bf16* hq; float* logf; bf16* hi; bf16* hsg; bf16* sbq; bf16* sbk; bf16* sbv;
    __device__ __forceinline__ void operator()(acc_t& acc, const Unit& u, int wr, int wc, int fr, int fq, int, int) const {
        const int row0 = u.pm * 256 + wr * 64 + fr; const int seg = u.pn >> 1; const int cseg0 = (u.pn & 1) * 256 + wc * 32 + 8 * fq;
        if (seg == 1) {
            float lb[2][8];
#pragma unroll
            for (int bj = 0; bj < 2; ++bj)
#pragma unroll
                for (int e = 0; e < 8; ++e) { const int c = cseg0 + bj * 128 + e; lb[bj][e] = rcpf_(1.0f + ex2((lbraw[HGW + c] - lbraw[c]) * LOG2E)); }
#pragma unroll
            for (int ai = 0; ai < 2; ++ai)
#pragma unroll
                for (int m = 0; m < 4; ++m) { const int row = row0 + ai * 128 + m * 16; const float r = rs_of(ss, row);
#pragma unroll
                    for (int bj = 0; bj < 2; ++bj) { f32x4 o[2];
#pragma unroll
                        for (int n = 0; n < 2; ++n)
#pragma unroll
                            for (int e = 0; e < 4; ++e) { const float v = acc[ai][bj][m][n][e] * r; const float l = lb[bj][4 * n + e]; const float f = l + (1.0f - l) * sigmoidf_(v); o[n][e] = lg2(f) * LN2; }
                        float* p = logf + (size_t)row * HGW + cseg0 + bj * 128; *(f32x4*)p = o[0]; *(f32x4*)(p + 4) = o[1]; } }
            return;
        }
#pragma unroll
        for (int ai = 0; ai < 2; ++ai)
#pragma unroll
            for (int m = 0; m < 4; ++m) { const int row = row0 + ai * 128 + m * 16; const float r = rs_of(ss, row);
#pragma unroll
                for (int bj = 0; bj < 2; ++bj) { f32x4 v0 = acc[ai][bj][m][0] * r, v1 = acc[ai][bj][m][1] * r; const int cs = cseg0 + bj * 128;
                    bf16* dst;
                    if (seg == 0) dst = hq + (size_t)row * HGW + cs;
                    else if (seg == 2) dst = hi + (size_t)row * HGW + cs;
                    else if (seg == 3) { dst = hsg + (size_t)row * HGW + cs;
#pragma unroll
                        for (int e = 0; e < 4; ++e) { v0[e] = siluf_(v0[e]); v1[e] = siluf_(v1[e]); } }
                    else { const int b = row >> 13, s = row & (SEQ - 1), head = cs >> 6, d = cs & 63; const size_t o = ((size_t)(b * SBH + head) * SEQ + s) * SBD + d;
                        if (seg == 4) { dst = sbq + o; v0 = v0 * SB_QSCALE; v1 = v1 * SB_QSCALE; } else if (seg == 5) dst = sbk + o; else dst = sbv + o; }
                    *(u32x4*)dst = pack8(v0, v1); } }
    }
};
struct EpiSoftmax {
    static constexpr bool PERM = true;
    bf16* P; PG8_LAS unsigned char* xl;
    __device__ __forceinline__ void operator()(acc_t& acc, const Unit& u, int wr, int wc, int fr, int fq, int, int) const {
        typedef float f32x2v __attribute__((ext_vector_type(2)));
        PG8_LAS f32x2v* X = (PG8_LAS f32x2v*)xl;
        float mw[2][4];
#pragma unroll
        for (int ai = 0; ai < 2; ++ai)
#pragma unroll
            for (int m = 0; m < 4; ++m) { float mx = -3.0e38f;
#pragma unroll
                for (int bj = 0; bj < 2; ++bj)
#pragma unroll
                    for (int n = 0; n < 2; ++n) { const f32x4 v = acc[ai][bj][m][n]; mx = fmaxf(fmaxf(fmaxf(mx, v[0]), fmaxf(v[1], v[2])), v[3]); }
                mx = fmaxf(mx, __shfl_xor(mx, 16)); mx = fmaxf(mx, __shfl_xor(mx, 32));
                float s = 0.f;
#pragma unroll
                for (int bj = 0; bj < 2; ++bj)
#pragma unroll
                    for (int n = 0; n < 2; ++n) { f32x4 v = acc[ai][bj][m][n];
#pragma unroll
                        for (int e = 0; e < 4; ++e) { v[e] = ex2(v[e] - mx); s += v[e]; }
                        acc[ai][bj][m][n] = v; }
                s += __shfl_xor(s, 16); s += __shfl_xor(s, 32);
                if (fq == 0) X[(ai * 128 + wr * 64 + m * 16 + fr) * 4 + wc] = (f32x2v){mx, s};
                mw[ai][m] = mx; }
        asm volatile("s_waitcnt lgkmcnt(0)" ::: "memory"); __builtin_amdgcn_s_barrier(); asm volatile("" ::: "memory");
        const int row0 = u.pm * 256 + wr * 64 + fr, col0 = u.pn * 256 + wc * 32 + 8 * fq;
#pragma unroll
        for (int ai = 0; ai < 2; ++ai)
#pragma unroll
            for (int m = 0; m < 4; ++m) { const int rl = ai * 128 + wr * 64 + m * 16 + fr;
                const f32x2v a = X[rl * 4 + 0], b = X[rl * 4 + 1], c = X[rl * 4 + 2], d = X[rl * 4 + 3];
                const float mt = fmaxf(fmaxf(a.x, b.x), fmaxf(c.x, d.x));
                const float tot = a.y * ex2(a.x - mt) + b.y * ex2(b.x - mt) + c.y * ex2(c.x - mt) + d.y * ex2(d.x - mt);
                const float f = ex2(mw[ai][m] - mt) * rcpf_(tot);
                const int row = row0 + ai * 128 + m * 16;
#pragma unroll
                for (int bj = 0; bj < 2; ++bj) *(u32x4*)(P + (size_t)row * D + col0 + bj * 128) = pack8(acc[ai][bj][m][0] * f, acc[ai][bj][m][1] * f); }
    }
};

struct CrossOrder {
    const char* A; const char* B; int G, c, mode;
    __device__ __forceinline__ bool next(int i, Unit& u) const {
        const int L = i * G + c; if (L >= 512) return false;
        u.pm = L >> 2; u.pn = L & 3; const int b = u.pm >> 5;
        u.a = A + ((size_t)u.pm * 256 * D + u.pn * 256) * 2;
        u.b = mode == 0 ? B + ((size_t)b * 256 * D + u.pn * 256) * 2 : B + ((size_t)u.pn * 256 * D + b * 256) * 2;
        return true;
    }
};
struct OneUnit {
    const char* a; const char* b; int pm, pn;
    __device__ __forceinline__ bool next(int i, Unit& u) const { if (i > 0) return false; u.pm = pm; u.pn = pn; u.a = a; u.b = b; return true; }
};

struct Args { const float* in[20]; float* out; unsigned char* ws; int ph_lo, ph_hi; };

__device__ __forceinline__ void transpose_item(const float* W, int K, int N, bf16* WT, const float* gain, int mode, LAS float* scr, int item, int lane) {
    const int nblk = N / 32, kb = item / nblk, nb = item % nblk, k0 = 64 * kb, n0 = 32 * nb;
#pragma unroll 8
    for (int i = 0; i < 32; ++i) { const int kk = 2 * i + (lane >> 5); const float g = gain ? gain[k0 + kk] : 1.0f; scr[kk * 33 + (lane & 31)] = W[(size_t)(k0 + kk) * N + n0 + (lane & 31)] * g; }
    LDS_WAIT(); asm volatile("" ::: "memory");
    int orow0 = n0;
    if (mode == 1) { const int j = n0 < FF ? n0 : n0 - FF; orow0 = (j >> 7) * 256 + (n0 < FF ? 0 : 128) + (j & 127); }
    const int c = lane & 7;
#pragma unroll
    for (int j = 0; j < 4; ++j) { const int n = (lane >> 3) + 8 * j; const LAS float* s = scr + (8 * c) * 33 + n;
        v4u o; o.x = pk2(s[0 * 33], s[1 * 33]); o.y = pk2(s[2 * 33], s[3 * 33]); o.z = pk2(s[4 * 33], s[5 * 33]); o.w = pk2(s[6 * 33], s[7 * 33]);
        *(GAS v4u*)(WT + (size_t)(orow0 + n) * K + k0 + 8 * c) = o; }
    LDS_WAIT(); asm volatile("" ::: "memory");
}

__global__ void __launch_bounds__(NWAVES * 64, 2) layer_fwd(Args args) {
    extern __shared__ __attribute__((aligned(16))) unsigned char lds_raw[];
    LAS unsigned char* lds = (LAS unsigned char*)lds_raw;
    volatile LAS unsigned* MISC = (volatile LAS unsigned*)(lds + MISC_OFF);
    const int tid = threadIdx.x, lane = tid & 63, wave = __builtin_amdgcn_readfirstlane(tid >> 6);
    const int G = gridDim.x, bx = blockIdx.x;
    const int vcu = (G % 8 == 0) ? (bx % 8) * (G / 8) + bx / 8 : bx;
    unsigned char* ws = args.ws;
    gu32* ctl = (gu32*)(ws + WS_CTL);
    float* ss0 = (float*)(ws + WS_SS); float* ss1 = ss0 + M; float* ss2 = ss1 + M; float* ss3 = ss2 + M;
    bf16* Wgu1 = (bf16*)(ws + WS_WGU1); bf16* Wd1 = (bf16*)(ws + WS_WD1); bf16* Win = (bf16*)(ws + WS_WIN); bf16* Wout = (bf16*)(ws + WS_WOUT);
    bf16* Wq = (bf16*)(ws + WS_WQ); bf16* Wkv = (bf16*)(ws + WS_WKV); bf16* Wo = (bf16*)(ws + WS_WO); bf16* Wgu2 = (bf16*)(ws + WS_WGU2); bf16* Wd2 = (bf16*)(ws + WS_WD2);
    bf16* MN = (bf16*)(ws + WS_MN); bf16* KMEM = (bf16*)(ws + WS_KMEM); bf16* VT = (bf16*)(ws + WS_VT);
    bf16* XB = (bf16*)(ws + WS_XB); bf16* HMID = (bf16*)(ws + WS_HMID);
    bf16* HQ = (bf16*)(ws + WS_HQ); float* LOGF = (float*)(ws + WS_LOGF); bf16* HI = (bf16*)(ws + WS_HI); bf16* HSG = (bf16*)(ws + WS_HSG);
    bf16* SBQ = (bf16*)(ws + WS_SBQ); bf16* SBK = (bf16*)(ws + WS_SBK); bf16* SBV = (bf16*)(ws + WS_SBV);
    bf16* MIXED = (bf16*)(ws + WS_MIXED); bf16* QC = (bf16*)(ws + WS_QC); bf16* PMb = (bf16*)(ws + WS_PM); bf16* OC = (bf16*)(ws + WS_OC);
    const float* x_in = args.in[0]; float* out = args.out;

    for (int u = tid; u < (LDS_BYTES - LDSCTL_OFF) / 4; u += NWAVES * 64) ((LAS unsigned*)(lds + LDSCTL_OFF))[u] = 0u;
    __syncthreads();
#if MK_ONE_LAUNCH
    XcdBarrier bar = xcd_barrier_post((unsigned*)(ctl + CW_BAR), MISC + 8);
#define GRID_BAR() xcd_barrier(bar)
#else
#define GRID_BAR() do { } while (0)
#endif
    const int lo = args.ph_lo, hi = args.ph_hi;
#define IN(k) (lo <= (k) && (k) < hi)
#define SEAM(k) do { if (IN(k) && IN((k) + 1)) GRID_BAR(); } while (0)
    const int gw = vcu * NWAVES + wave, NGW = G * NWAVES;

    if (IN(0)) {
        LAS float* scr = (LAS float*)(lds + wave * 16384);
        constexpr int I_GU = (D / 64) * (GU / 32), I_DN = (FF / 64) * (D / 32), I_IN = (D / 64) * (INC / 32), I_SQ = (D / 64) * (D / 32), I_KV = (D / 64) * (2 * D / 32);
        constexpr int NITEMS = 2 * I_GU + 2 * I_DN + I_IN + 3 * I_SQ + I_KV;
        for (int it = gw; it < NITEMS; it += NGW) {
            int r = it;
            if (r < I_GU) { transpose_item(args.in[3], D, GU, Wgu1, args.in[2], 1, scr, r, lane); continue; } r -= I_GU;
            if (r < I_GU) { transpose_item(args.in[17], D, GU, Wgu2, args.in[16], 1, scr, r, lane); continue; } r -= I_GU;
            if (r < I_DN) { transpose_item(args.in[4], FF, D, Wd1, nullptr, 0, scr, r, lane); continue; } r -= I_DN;
            if (r < I_DN) { transpose_item(args.in[18], FF, D, Wd2, nullptr, 0, scr, r, lane); continue; } r -= I_DN;
            if (r < I_IN) { transpose_item(args.in[6], D, INC, Win, args.in[5], 0, scr, r, lane); continue; } r -= I_IN;
            if (r < I_SQ) { transpose_item(args.in[10], D, D, Wout, nullptr, 0, scr, r, lane); continue; } r -= I_SQ;
            if (r < I_SQ) { transpose_item(args.in[13], D, D, Wq, args.in[11], 0, scr, r, lane); continue; } r -= I_SQ;
            if (r < I_SQ) { transpose_item(args.in[15], D, D, Wo, nullptr, 0, scr, r, lane); continue; } r -= I_SQ;
            transpose_item(args.in[14], D, 2 * D, Wkv, nullptr, 0, scr, r, lane);
        }
        for (int m = gw; m < M; m += NGW) {
            const GAS f32x4* xr = (const GAS f32x4*)(x_in + (size_t)m * D) + lane; f32x4 v[4]; float s = 0.f;
#pragma unroll
            for (int j = 0; j < 4; ++j) { v[j] = xr[64 * j]; s += (v[j].x * v[j].x + v[j].y * v[j].y) + (v[j].z * v[j].z + v[j].w * v[j].w); }
            s = wave_sum(s);
            GAS unsigned long long* o8 = (GAS unsigned long long*)(XB + (size_t)m * D) + lane;
#pragma unroll
            for (int j = 0; j < 4; ++j) o8[64 * j] = (unsigned long long)pk2(v[j].x, v[j].y) | ((unsigned long long)pk2(v[j].z, v[j].w) << 32);
            if (lane == 0) ss0[m] = s;
        }
        for (int m = gw; m < MROWS; m += NGW) {
            const GAS f32x4* xr = (const GAS f32x4*)(args.in[1] + (size_t)m * D) + lane; const GAS f32x4* gr = (const GAS f32x4*)(args.in[12]) + lane; f32x4 v[4]; float s = 0.f;
#pragma unroll
            for (int j = 0; j < 4; ++j) { v[j] = xr[64 * j]; s += (v[j].x * v[j].x + v[j].y * v[j].y) + (v[j].z * v[j].z + v[j].w * v[j].w); }
            const float r = __builtin_amdgcn_rsqf(wave_sum(s) * (1.0f / (float)D) + EPS);
            GAS unsigned long long* o8 = (GAS unsigned long long*)(MN + (size_t)m * D) + lane;
#pragma unroll
            for (int j = 0; j < 4; ++j) { const f32x4 g = gr[64 * j]; o8[64 * j] = (unsigned long long)pk2(v[j].x * r * g.x, v[j].y * r * g.y) | ((unsigned long long)pk2(v[j].z * r * g.z, v[j].w * r * g.w) << 32); }
        }
    }
    SEAM(0);
    if (IN(1)) { pg8::TileOrder S; S.init(XB, Wgu1, D, D, M, GU, G, bx); EpiSwiglu E{HMID, ss0}; pg8::gemm_phase(lds, D, D, D, S, E); }
    SEAM(1);
    if (IN(2)) { pg8::TileOrder S; S.init(HMID, Wd1, FF, FF, M, D, G, bx); EpiResid E{x_in, out, XB, ss1, 0.5f}; pg8::gemm_phase(lds, FF, FF, FF, S, E); }
    SEAM(2);
    if (IN(3)) { pg8::TileOrder S; S.init(XB, Win, D, D, M, INC, G, bx); EpiWin E{ss1, args.in[7], HQ, LOGF, HI, HSG, SBQ, SBK, SBV}; pg8::gemm_phase(lds, D, D, D, S, E); }
    SEAM(3);
    if (IN(4)) {
        if (bx < 16) {
            const int b = bx >> 2, h = bx & 3, dq = tid & 3, dv = tid >> 2;
            LAS float* Fs = (LAS float*)lds; LAS float* Qs = Fs + 8192; LAS float* Is = Qs + 8192; LAS float* Os = Is + 8192;
            float St[32];
#pragma unroll
            for (int j = 0; j < 32; ++j) St[j] = 0.f;
            const float* ghg = args.in[8];
            for (int t0 = 0; t0 < SEQ; t0 += 64) {
                const size_t rbase = (size_t)b * SEQ + t0;
#pragma unroll 4
                for (int i = 0; i < 16; ++i) { const int idx = tid + 512 * i, r = idx >> 7, c = idx & 127; const size_t g = (rbase + r) * HGW + h * HGD + c;
                    Fs[idx] = ex2(LOGF[g] * LOG2E); Qs[idx] = bf2f(HQ[g]); Is[idx] = bf2f(HI[g]); }
                __syncthreads();
                for (int tt = 0; tt < 64; ++tt) {
                    const float iv = Is[tt * 128 + dv]; float o = 0.f;
#pragma unroll
                    for (int j4 = 0; j4 < 8; ++j4) { const f32x4 f4 = *(const LAS f32x4*)(Fs + tt * 128 + dq * 32 + j4 * 4), q4 = *(const LAS f32x4*)(Qs + tt * 128 + dq * 32 + j4 * 4);
#pragma unroll
                        for (int e = 0; e < 4; ++e) { float s = St[j4 * 4 + e]; s = iv + f4[e] * (s - iv); St[j4 * 4 + e] = s; o += s * q4[e]; } }
                    o += __shfl_xor(o, 1); o += __shfl_xor(o, 2);
                    if (dq == 0) Os[tt * 128 + dv] = o;
                }
                __syncthreads();
                for (int k = 0; k < 8; ++k) { const int tt = wave * 8 + k; const float v0 = Os[tt * 128 + lane], v1 = Os[tt * 128 + 64 + lane];
                    const float r = __builtin_amdgcn_rsqf(wave_sum(v0 * v0 + v1 * v1) * (1.0f / (float)HGD) + EPS);
                    const size_t row = rbase + tt; const int c0 = h * HGD + lane, c1 = c0 + 64;
                    MIXED[row * D + c0] = (bf16)f2bf(v0 * r * ghg[c0] * bf2f(HSG[row * HGW + c0]));
                    MIXED[row * D + c1] = (bf16)f2bf(v1 * r * ghg[c1] * bf2f(HSG[row * HGW + c1])); }
                __syncthreads();
            }
        } else if (bx < 32) {
            const int L = bx - 16; OneUnit S{(const char*)(MN + (size_t)(L >> 2) * 256 * D), (const char*)(Wkv + (size_t)(L & 3) * 256 * D), L >> 2, L & 3};
            EpiPlain E{KMEM, D, nullptr, 1.0f}; pg8::gemm_phase(lds, D, D, D, S, E);
        } else if (bx < 48) {
            const int L = bx - 32; OneUnit S{(const char*)(Wkv + (size_t)(D + (L >> 2) * 256) * D), (const char*)(MN + (size_t)(L & 3) * 256 * D), L >> 2, L & 3};
            EpiPlain E{VT, D, nullptr, 1.0f}; pg8::gemm_phase(lds, D, D, D, S, E);
        } else {
            const int sw = (bx - 48) * NWAVES + wave, nsw = (G - 48) * NWAVES; const float* gsb = args.in[9];
            for (int R = sw; R < BATCH * SBH * SEQ; R += nsw) {
                const int t = R & (SEQ - 1), bh = R >> 13, h = bh & 7, b = bh >> 3;
                const bf16* kbase = SBK + (size_t)bh * SEQ * SBD; const bf16* vbase = SBV + (size_t)bh * SEQ * SBD;
                const float qf = bf2f(SBQ[(size_t)R * SBD + lane]);
                float o = 0.f, carry = 0.f;
                if (t > 0) for (int tile = (t - 1) >> 6; tile >= 0; --tile) {
                    const int s = tile * 64 + lane; const bool valid = s < t;
                    const v4u* kr = (const v4u*)(kbase + (size_t)s * SBD); float z = 0.f;
#pragma unroll
                    for (int c8 = 0; c8 < 8; ++c8) { const v4u kv = kr[c8];
                        z += rdlane(qf, c8 * 8 + 0) * bf_lo(kv.x) + rdlane(qf, c8 * 8 + 1) * bf_hi(kv.x) + rdlane(qf, c8 * 8 + 2) * bf_lo(kv.y) + rdlane(qf, c8 * 8 + 3) * bf_hi(kv.y)
                           + rdlane(qf, c8 * 8 + 4) * bf_lo(kv.z) + rdlane(qf, c8 * 8 + 5) * bf_hi(kv.z) + rdlane(qf, c8 * 8 + 6) * bf_lo(kv.w) + rdlane(qf, c8 * 8 + 7) * bf_hi(kv.w); }
                    const float sp = valid ? fmaxf(z, 0.f) + lg2(1.0f + ex2(-fabsf(z))) : 0.f;
                    float suf = sp;
#pragma unroll
                    for (int off = 1; off < 64; off <<= 1) { const float v = __shfl_down(suf, off); if (lane + off < 64) suf += v; }
                    const float w = valid ? ex2(z - (carry + suf)) : 0.f;
                    const bf16* vt = vbase + (size_t)tile * 64 * SBD + lane;
#pragma unroll 8
                    for (int j = 0; j < 64; ++j) o += rdlane(w, j) * bf2f(vt[j * SBD]);
                    carry += rdlane(suf, 0);
                    if (carry > SB_STOP) break;
                }
                const float r = __builtin_amdgcn_rsqf(wave_sum(o * o) * (1.0f / (float)SBD) + EPS);
                MIXED[((size_t)b * SEQ + t) * D + HGW + h * SBD + lane] = (bf16)f2bf(o * r * gsb[h * SBD + lane]);
            }
        }
    }
    SEAM(4);
    if (IN(5)) { pg8::TileOrder S; S.init(MIXED, Wout, D, D, M, D, G, bx); EpiResid E{out, out, XB, ss2, 1.0f}; pg8::gemm_phase(lds, D, D, D, S, E); }
    SEAM(5);
    if (IN(6)) { pg8::TileOrder S; S.init(XB, Wq, D, D, M, D, G, bx); EpiPlain E{QC, D, ss2, CA_QSCALE}; pg8::gemm_phase(lds, D, D, D, S, E); }
    SEAM(6);
    if (IN(7)) { CrossOrder S{(const char*)QC, (const char*)KMEM, G, bx, 0}; EpiSoftmax E{PMb, lds + EPI_OFF}; int kc = CHD; asm volatile("" : "+s"(kc)); pg8::gemm_phase(lds, kc, D, D, S, E); }
    SEAM(7);
    if (IN(8)) { CrossOrder S{(const char*)PMb, (const char*)VT, G, bx, 1}; EpiPlain E{OC, D, nullptr, 1.0f}; int kc = NMEM; asm volatile("" : "+s"(kc)); pg8::gemm_phase(lds, kc, D, D, S, E); }
    SEAM(8);
    if (IN(9)) { pg8::TileOrder S; S.init(OC, Wo, D, D, M, D, G, bx); EpiResid E{out, out, XB, ss3, 1.0f}; pg8::gemm_phase(lds, D, D, D, S, E); }
    SEAM(9);
    if (IN(10)) { pg8::TileOrder S; S.init(XB, Wgu2, D, D, M, GU, G, bx); EpiSwiglu E{HMID, ss3}; pg8::gemm_phase(lds, D, D, D, S, E); }
    SEAM(10);
    if (IN(11)) { pg8::TileOrder S; S.init(HMID, Wd2, FF, FF, M, D, G, bx); EpiResid E{out, out, XB, nullptr, 0.5f}; pg8::gemm_phase(lds, FF, FF, FF, S, E); }
    SEAM(11);
    if (IN(12)) {
        const GAS f32x4* gr = (const GAS f32x4*)(args.in[19]) + lane;
        for (int m = gw; m < M; m += NGW) {
            GAS f32x4* xr = (GAS f32x4*)(out + (size_t)m * D) + lane; f32x4 v[4]; float s = 0.f;
#pragma unroll
            for (int j = 0; j < 4; ++j) { v[j] = xr[64 * j]; s += (v[j].x * v[j].x + v[j].y * v[j].y) + (v[j].z * v[j].z + v[j].w * v[j].w); }
            const float r = __builtin_amdgcn_rsqf(wave_sum(s) * (1.0f / (float)D) + EPS);
#pragma unroll
            for (int j = 0; j < 4; ++j) { const f32x4 g = gr[64 * j]; xr[64 * j] = v[j] * r * g; }
        }
    }
#undef IN
#undef SEAM
}

constexpr int N_PHASES = 13;
extern "C" void kernel_launch(void* const* d_in, const int* in_sizes, int n_in, void* d_out, int out_size, void* d_ws, size_t ws_size, hipStream_t stream) {
    static int grid = 0;
    if (grid == 0) {
        if (n_in != 20 || in_sizes[0] != M * D || out_size != M * D || ws_size < WS_END) { fprintf(stderr, "kernel_launch: unexpected shapes (n_in %d, in0 %d, out %d, ws %zu)\n", n_in, n_in > 0 ? in_sizes[0] : -1, out_size, ws_size); grid = -1; return; }
        int dev = 0, cus = 0;
        if (hipGetDevice(&dev) != hipSuccess || hipDeviceGetAttribute(&cus, hipDeviceAttributeMultiprocessorCount, dev) != hipSuccess) { grid = -1; return; }
        if (hipFuncSetAttribute((const void*)layer_fwd, hipFuncAttributeMaxDynamicSharedMemorySize, LDS_BYTES) != hipSuccess) { fprintf(stderr, "kernel_launch: hipFuncSetAttribute failed\n"); grid = -1; return; }
        int per_cu = 0;
        if (hipOccupancyMaxActiveBlocksPerMultiprocessor(&per_cu, (const void*)layer_fwd, NWAVES * 64, LDS_BYTES) != hipSuccess || per_cu < 1) fprintf(stderr, "kernel_launch: occupancy query says %d\n", per_cu);
        (void)hipGetLastError();
        grid = cus;
    }
    if (grid < 0) return;
    if (hipMemsetAsync((char*)d_ws + WS_CTL, 0, CTL_ZERO_BYTES, stream) != hipSuccess) return;
    Args a{};
    for (int i = 0; i < 20; ++i) a.in[i] = (const float*)d_in[i];
    a.out = (float*)d_out; a.ws = (unsigned char*)d_ws;
#if MK_ONE_LAUNCH
    a.ph_lo = 0; a.ph_hi = N_PHASES;
    hipLaunchKernelGGL(layer_fwd, dim3(grid), dim3(NWAVES * 64), LDS_BYTES, stream, a);
#else
    for (int p = 0; p < N_PHASES; ++p) { a.ph_lo = p; a.ph_hi = p + 1; hipLaunchKernelGGL(layer_fwd, dim3(grid), dim3(NWAVES * 64), LDS_BYTES, stream, a); }
#endif
}
```

```cpp
#include <hip/hip_runtime.h>
#include <cstdio>
#include <cstdint>

#ifndef MK_ONE_LAUNCH
#define MK_ONE_LAUNCH 1
#endif

namespace pg8 {
#define PG8_LAS __attribute__((address_space(3)))
typedef unsigned short bf16_t;
typedef short bf16x8 __attribute__((ext_vector_type(8)));
typedef float f32x4 __attribute__((ext_vector_type(4)));
typedef float f32x2 __attribute__((ext_vector_type(2)));
typedef unsigned u32x4 __attribute__((ext_vector_type(4)));
constexpr int BM = 256, BK = 64, HALF = 128, HTB = HALF * BK * 2, STAGE_BYTES = 8 * HTB, NXCD = 8, WGM = 8;

__host__ __device__ __forceinline__ int lds_byte(int r, int c) { const int st = (r >> 4) * 2 + (c >> 5), rr = r & 15, cc = c & 31, ob = rr * 64 + cc * 2; return st * 1024 + (ob ^ (((ob >> 9) & 1) << 5)); }
__host__ __device__ __forceinline__ void stage_rc(int b, int& R, int& C) { const int st = b / 1024, sb = b % 1024, swz = sb ^ (((sb >> 9) & 1) << 5); R = (st >> 1) * 16 + swz / 64; C = (st & 1) * 32 + (swz % 64) / 2; }
__host__ __device__ __forceinline__ int perm32(int rho) { const int n = rho >> 4, i = rho & 15; return 8 * (i >> 2) + 4 * n + (i & 3); }

struct Unit { int pm, pn; const char* a; const char* b; };

__device__ __forceinline__ unsigned cvt_pk_bf16(float lo, float hi) { unsigned r; asm volatile("v_cvt_pk_bf16_f32 %0, %1, %2" : "=v"(r) : "v"(lo), "v"(hi)); return r; }

struct TileOrder {
    const char* A; const char* B; int lda, ldb; int nM, nN, nwg, G, c;
    __device__ __forceinline__ void init(const void* A_, const void* B_, int lda_, int ldb_, int M, int N, int G_, int c_) { A = (const char*)A_; B = (const char*)B_; lda = lda_; ldb = ldb_; nM = M / BM; nN = N / BM; nwg = nM * nN; G = G_; c = c_; }
    __device__ __forceinline__ bool next(int i, Unit& u) const {
        const long L = (long)i * G + c; if (L >= nwg) return false;
        int wgid = (int)L; { const int q = nwg / NXCD, r = nwg % NXCD, xcd = wgid % NXCD, off = wgid / NXCD; wgid = (xcd < r ? xcd * (q + 1) : r * (q + 1) + (xcd - r) * q) + off; }
        const int nig = WGM * nN, gid = wgid / nig, fm = gid * WGM, gsz = (nM - fm) < WGM ? (nM - fm) : WGM;
        u.pm = fm + ((wgid % nig) % gsz); u.pn = (wgid % nig) / gsz;
        u.a = A + (size_t)u.pm * BM * lda * 2; u.b = B + (size_t)u.pn * BM * ldb * 2; return true;
    }
};

template <class Epi, class Sched>
__device__ __forceinline__ void gemm_phase(PG8_LAS unsigned char* lds, const int K, const int lda, const int ldb, const Sched& S, const Epi& E) {
    const int tid = threadIdx.x, wid = __builtin_amdgcn_readfirstlane(tid >> 6), lane = tid & 63, wr = wid >> 2, wc = wid & 3, fr = lane & 15, fq = lane >> 4;
    const int nt = K / BK;
    unsigned voffA[2], voffB[2];
#pragma unroll
    for (int i = 0; i < 2; ++i) { int R, C; stage_rc(tid * 16 + i * 8192, R, C); const int Rb = Epi::PERM ? ((R & ~31) + perm32(R & 31)) : R;
        voffA[i] = (unsigned)(R * lda + C) * 2u; voffB[i] = (unsigned)(Rb * ldb + C) * 2u; }
    const size_t kstep = (size_t)(BK * 2);
    const size_t hstepA = (size_t)HALF * lda * 2, hstepB = (size_t)HALF * ldb * 2;
    const unsigned ldsw = (unsigned)wid * 1024u;
    const int aoff = lds_byte(wr * 64 + fr, fq * 8), boff = lds_byte(wc * 32 + fr, fq * 8);
#define PG8_SA(b, h) (((b) * 2 + (h)) * HTB)
#define PG8_SB(b, h) ((4 + (b) * 2 + (h)) * HTB)
#define PG8_STAGE(bufoff, gbase, voff) do { _Pragma("unroll") for (int _i = 0; _i < 2; ++_i) \
        __builtin_amdgcn_global_load_lds((const unsigned*)((const char*)(gbase) + (voff)[_i]), (PG8_LAS unsigned*)(lds + (bufoff) + ldsw + _i * 8192), 16, 0, 0); } while (0)
#define PG8_LDA(dst, b, h) do { _Pragma("unroll") for (int m = 0; m < 4; ++m) _Pragma("unroll") for (int k = 0; k < 2; ++k) dst[m][k] = *(const PG8_LAS bf16x8*)(lds + PG8_SA(b, h) + aoff + m * 2048 + k * 1024); } while (0)
#define PG8_LDB(dst, b, h) do { _Pragma("unroll") for (int n = 0; n < 2; ++n) _Pragma("unroll") for (int k = 0; k < 2; ++k) dst[n][k] = *(const PG8_LAS bf16x8*)(lds + PG8_SB(b, h) + boff + n * 2048 + k * 1024); } while (0)
#define PG8_MMA(ai, bj, At, Bt) do { __builtin_amdgcn_s_setprio(1); _Pragma("unroll") for (int m = 0; m < 4; ++m) _Pragma("unroll") for (int n = 0; n < 2; ++n) _Pragma("unroll") for (int k = 0; k < 2; ++k) \
        acc[ai][bj][m][n] = __builtin_amdgcn_mfma_f32_16x16x32_bf16(Bt[n][k], At[m][k], acc[ai][bj][m][n], 0, 0, 0); __builtin_amdgcn_s_setprio(0); } while (0)
#define PG8_WAIT_V(n) asm volatile("s_waitcnt vmcnt(" #n ")" ::: "memory")
#define PG8_WAIT_L(n) asm volatile("s_waitcnt lgkmcnt(" #n ")" ::: "memory")
#define PG8_BAR __builtin_amdgcn_s_barrier()
#define PG8_SCHED __builtin_amdgcn_sched_barrier(0)
    Unit cur, nxt; int ui = 0;
    if (!S.next(0, cur)) return;
    f32x4 acc[2][2][4][2];
#pragma unroll
    for (int a = 0; a < 2; ++a)
#pragma unroll
        for (int b = 0; b < 2; ++b)
#pragma unroll
            for (int m = 0; m < 4; ++m)
#pragma unroll
                for (int n = 0; n < 2; ++n) acc[a][b][m][n] = (f32x4){0.f, 0.f, 0.f, 0.f};
    bf16x8 At[4][2], B0[2][2], B1[2][2];
    const char* cA = cur.a; const char* cB = cur.b;
    PG8_STAGE(PG8_SB(0, 0), cB, voffB); PG8_STAGE(PG8_SB(0, 1), cB + hstepB, voffB); PG8_STAGE(PG8_SA(0, 0), cA, voffA); PG8_STAGE(PG8_SA(0, 1), cA + hstepA, voffA);
    if (wr == 1) PG8_BAR;
    PG8_WAIT_V(2); PG8_BAR;
    PG8_STAGE(PG8_SB(1, 0), cB + kstep, voffB); PG8_STAGE(PG8_SA(1, 0), cA + kstep, voffA); PG8_STAGE(PG8_SB(1, 1), cB + hstepB + kstep, voffB);
    PG8_WAIT_V(6); PG8_BAR;
    for (;;) {
        const bool has_next = S.next(ui + 1, nxt);
        const char* nA = has_next ? nxt.a : cA; const char* nB = has_next ? nxt.b : cB;
        for (int t = 0; t < nt; t += 2) {
            const bool last = (t == nt - 2);
            const char* a1 = cA + (size_t)(t + 1) * kstep;
            const char* a2 = last ? nA : cA + (size_t)(t + 2) * kstep; const char* b2 = last ? nB : cB + (size_t)(t + 2) * kstep;
            const char* a3 = a2 + kstep; const char* b3 = b2 + kstep;
            PG8_LDB(B0, 0, 0); PG8_LDB(B1, 0, 1); PG8_SCHED; PG8_LDA(At, 0, 0); PG8_STAGE(PG8_SA(1, 1), a1 + hstepA, voffA);
            PG8_WAIT_V(8); PG8_WAIT_L(0); PG8_BAR; PG8_MMA(0, 0, At, B0); PG8_MMA(0, 1, At, B1); PG8_BAR; PG8_SCHED;
            PG8_LDA(At, 0, 1); PG8_STAGE(PG8_SB(0, 0), b2, voffB); PG8_STAGE(PG8_SB(0, 1), b2 + hstepB, voffB); PG8_STAGE(PG8_SA(0, 0), a2, voffA);
            PG8_WAIT_V(8); PG8_WAIT_L(0); PG8_BAR; PG8_MMA(1, 0, At, B0); PG8_MMA(1, 1, At, B1); PG8_BAR; PG8_SCHED;
            PG8_LDB(B0, 1, 0); PG8_LDB(B1, 1, 1); PG8_SCHED; PG8_LDA(At, 1, 0); PG8_STAGE(PG8_SA(0, 1), a2 + hstepA, voffA);
            PG8_WAIT_V(8); PG8_WAIT_L(0); PG8_BAR; PG8_MMA(0, 0, At, B0); PG8_MMA(0, 1, At, B1); PG8_BAR; PG8_SCHED;
            PG8_LDA(At, 1, 1); PG8_STAGE(PG8_SB(1, 0), b3, voffB); PG8_STAGE(PG8_SB(1, 1), b3 + hstepB, voffB); PG8_STAGE(PG8_SA(1, 0), a3, voffA);
            PG8_WAIT_V(8); PG8_WAIT_L(0); PG8_BAR; PG8_MMA(1, 0, At, B0); PG8_MMA(1, 1, At, B1); PG8_BAR; PG8_SCHED;
        }
        if (wr == 0) PG8_BAR;
        E(acc, cur, wr, wc, fr, fq, wid, lane);
        if (!has_next) break;
#pragma unroll
        for (int a = 0; a < 2; ++a)
#pragma unroll
            for (int b = 0; b < 2; ++b)
#pragma unroll
                for (int m = 0; m < 4; ++m)
#pragma unroll
                    for (int n = 0; n < 2; ++n) acc[a][b][m][n] = (f32x4){0.f, 0.f, 0.f, 0.f};
        cur = nxt; cA = nA; cB = nB; ++ui;
        if (wr == 1) PG8_BAR;
    }
    PG8_WAIT_V(0);
    PG8_BAR;
#undef PG8_SA
#undef PG8_SB
#undef PG8_STAGE
#undef PG8_LDA
#undef PG8_LDB
#undef PG8_MMA
#undef PG8_WAIT_V
#undef PG8_WAIT_L
#undef PG8_BAR
#undef PG8_SCHED
}
}

constexpr int NWAVES = 8;
constexpr int BATCH = 4, SEQ = 8192, D = 1024, M = BATCH * SEQ;
constexpr int FF = 2816, GU = 2 * FF, INC = 3584, NMEM = 256, MROWS = BATCH * NMEM;
constexpr int HGW = 512, HGH = 4, HGD = 128, SBW = 512, SBH = 8, SBD = 64, CHD = 256;
constexpr float EPS = 1e-6f, LOG2E = 1.4426950408889634f, LN2 = 0.6931471805599453f;
constexpr float SB_QSCALE = 0.125f * LOG2E;
constexpr float CA_QSCALE = 0.0625f * LOG2E;
constexpr float SB_STOP = 160.0f;

constexpr size_t MiB = 1u << 20;
constexpr size_t WS_CTL = 0, CTL_ZERO_BYTES = 2 * MiB;
constexpr size_t WS_SS = 1 * MiB;
constexpr size_t WS_WGU1 = 2 * MiB, WS_WD1 = 13 * MiB, WS_WIN = 19 * MiB, WS_WOUT = 26 * MiB, WS_WQ = 28 * MiB, WS_WKV = 30 * MiB, WS_WO = 34 * MiB, WS_WGU2 = 36 * MiB, WS_WD2 = 47 * MiB;
constexpr size_t WS_MN = 53 * MiB, WS_KMEM = 55 * MiB, WS_VT = 57 * MiB;
constexpr size_t WS_XB = 64 * MiB;
constexpr size_t WS_HMID = 128 * MiB;
constexpr size_t WS_HQ = 128 * MiB, WS_LOGF = 160 * MiB, WS_HI = 224 * MiB, WS_HSG = 256 * MiB;
constexpr size_t WS_SBQ = 304 * MiB, WS_SBK = 336 * MiB, WS_SBV = 368 * MiB;
constexpr size_t WS_MIXED = 400 * MiB;
constexpr size_t WS_QC = 128 * MiB, WS_PM = 192 * MiB, WS_OC = 304 * MiB;
constexpr size_t WS_END = 464 * MiB;
constexpr int CW_TMO = 0, CW_CODE = 1, CW_BAR = 4096;

constexpr int RING_BYTES = 131072;
constexpr int LDSCTL_OFF = RING_BYTES, MISC_OFF = LDSCTL_OFF + 320;
constexpr int EPI_OFF = RING_BYTES + 1024;
constexpr int LDS_BYTES = 147456;

#define GAS __attribute__((address_space(1)))
#define LAS __attribute__((address_space(3)))
typedef unsigned short bf16;
typedef unsigned v4u __attribute__((ext_vector_type(4)));
typedef float f32x4 __attribute__((ext_vector_type(4)));
typedef GAS unsigned gu32;
#define RLX_AGENT __ATOMIC_RELAXED, __HIP_MEMORY_SCOPE_AGENT
#define LDS_WAIT() asm volatile("s_waitcnt lgkmcnt(0)" ::: "memory")
#define VM_WAIT() asm volatile("s_waitcnt vmcnt(0)" ::: "memory")
__device__ __forceinline__ unsigned f2bf(float f) { unsigned u = __builtin_bit_cast(unsigned, f); return (u + 0x7fffu + ((u >> 16) & 1u)) >> 16; }
__device__ __forceinline__ unsigned pk2(float lo, float hi) { return f2bf(lo) | (f2bf(hi) << 16); }
__device__ __forceinline__ float bf_lo(unsigned w) { return __builtin_bit_cast(float, w << 16); }
__device__ __forceinline__ float bf_hi(unsigned w) { return __builtin_bit_cast(float, w & 0xffff0000u); }
__device__ __forceinline__ float bf2f(bf16 h) { return __builtin_bit_cast(float, (unsigned)h << 16); }
__device__ __forceinline__ float ex2(float x) { return __builtin_amdgcn_exp2f(x); }
__device__ __forceinline__ float lg2(float x) { return __builtin_amdgcn_logf(x); }
__device__ __forceinline__ float rcpf_(float x) { return __builtin_amdgcn_rcpf(x); }
__device__ __forceinline__ float sigmoidf_(float v) { return rcpf_(1.0f + ex2(-v * LOG2E)); }
__device__ __forceinline__ float siluf_(float v) { return v * sigmoidf_(v); }
__device__ __forceinline__ float rdlane(float v, int l) { return __builtin_bit_cast(float, __builtin_amdgcn_readlane(__builtin_bit_cast(int, v), l)); }
__device__ __forceinline__ float wave_sum(float v) {
#pragma unroll
    for (int o = 1; o < 64; o <<= 1) v += __shfl_xor(v, o);
    return v;
}

#define XB_TMO      128
#define XB_XCNT(j)  (256  + 64 * (j))
#define XB_XSUB(j)  (1280 + 64 * (j))
#define XB_XGEN(j)  (2304 + 64 * (j))
#define XB_TOP      3328
#define XB_TOPGEN   3392
#define XCD_BAR_WORDS 3456
#define XB_SPIN_CAP (1u << 18)
__device__ __forceinline__ unsigned xb_ld(unsigned* p)              { return __hip_atomic_load(p, __ATOMIC_RELAXED, __HIP_MEMORY_SCOPE_AGENT); }
__device__ __forceinline__ unsigned xb_add(unsigned* p, unsigned v) { return __hip_atomic_fetch_add(p, v, __ATOMIC_RELAXED, __HIP_MEMORY_SCOPE_AGENT); }
__device__ __forceinline__ unsigned xb_xcc_id() { return (unsigned)__builtin_amdgcn_s_getreg((3 << 11) | 20) & 0xFu; }
#define XB_SPIN(cond, bar) do { unsigned _sp = 0; while (cond) { __builtin_amdgcn_s_sleep(1); \
    if ((++_sp & 255u) == 0u) { if (xb_ld(&(bar)[XB_TMO])) break; if (_sp > XB_SPIN_CAP) { atomicAdd(&(bar)[XB_TMO], 1u); break; } } } } while (0)
struct XcdBarrier { unsigned* bar; unsigned x; volatile LAS unsigned* st; };
__device__ __forceinline__ XcdBarrier xcd_barrier_post(unsigned* bar, volatile LAS unsigned* st) {
    XcdBarrier b; b.bar = bar; b.x = xb_xcc_id(); b.st = st;
    if (threadIdx.x == 0) (void)xb_add(&bar[XB_XCNT(b.x)], 1u);
    return b;
}
__device__ __forceinline__ void xcd_barrier_complete(unsigned* bar, unsigned x, unsigned& nloc, unsigned& nx) {
    const unsigned G = gridDim.x * gridDim.y * gridDim.z;
    unsigned sum, cnt, mine, sp = 0u;
    for (;;) {
        sum = 0u; cnt = 0u; mine = 0u;
#pragma unroll
        for (unsigned j = 0; j < 16; ++j) { const unsigned c = xb_ld(&bar[XB_XCNT(j)]); sum += c; cnt += (c > 0u) ? 1u : 0u; mine = (j == x) ? c : mine; }
        if (sum == G) break;
        __builtin_amdgcn_s_sleep(1);
        if ((++sp & 255u) == 0u) { if (xb_ld(&bar[XB_TMO])) break; if (sp > XB_SPIN_CAP) { atomicAdd(&bar[XB_TMO], 1u); break; } }
    }
    nloc = mine > 0u ? mine : 1u; nx = cnt > 0u ? cnt : 1u;
}
__device__ __forceinline__ void xcd_barrier(const XcdBarrier& b) {
    asm volatile("s_waitcnt vmcnt(0)" ::: "memory");
    __syncthreads();
    if (threadIdx.x == 0) {
        unsigned* bar = b.bar;
        __builtin_amdgcn_s_waitcnt(0);
        unsigned nloc = b.st[0], nx = b.st[1];
        if (nloc == 0u) { xcd_barrier_complete(bar, b.x, nloc, nx); b.st[0] = nloc; b.st[1] = nx; }
        const unsigned old = xb_add(&bar[XB_XSUB(b.x)], 1u);
        const unsigned gen = old / nloc;
        if (old + 1u == (gen + 1u) * nloc) {
            __builtin_amdgcn_fence(__ATOMIC_RELEASE, "agent");
            asm volatile("s_waitcnt vmcnt(0)" ::: "memory");
            const unsigned og = xb_add(&bar[XB_TOP], 1u);
            const unsigned tg = og / nx;
            if (og + 1u == (tg + 1u) * nx) xb_add(&bar[XB_TOPGEN], 1u);
            else XB_SPIN(xb_ld(&bar[XB_TOPGEN]) == tg, bar);
            __builtin_amdgcn_fence(__ATOMIC_ACQUIRE, "agent");
            xb_add(&bar[XB_XGEN(b.x)], 1u);
            asm volatile("s_waitcnt vmcnt(0)" ::: "memory");
        } else {
            XB_SPIN(xb_ld(&bar[XB_XGEN(b.x)]) == gen, bar);
            __builtin_amdgcn_fence(__ATOMIC_ACQUIRE, "agent");
            asm volatile("s_waitcnt vmcnt(0)" ::: "memory");
        }
    }
    __syncthreads();
}

using pg8::f32x4; using pg8::u32x4; using pg8::Unit; using pg8::cvt_pk_bf16;
typedef f32x4 acc_t[2][2][4][2];
__device__ __forceinline__ float rs_of(const float* ss, int row) { return __builtin_amdgcn_rsqf(ss[row] * (1.0f / (float)D) + EPS); }
__device__ __forceinline__ u32x4 pack8(const f32x4 a, const f32x4 b) { u32x4 w; w.x = cvt_pk_bf16(a[0], a[1]); w.y = cvt_pk_bf16(a[2], a[3]); w.z = cvt_pk_bf16(b[0], b[1]); w.w = cvt_pk_bf16(b[2], b[3]); return w; }

struct EpiSwiglu {
    static constexpr bool PERM = true;
    bf16* H; const float* ss;
    __device__ __forceinline__ void operator()(acc_t& acc, const Unit& u, int wr, int wc, int fr, int fq, int, int) const {
        const int row0 = u.pm * 256 + wr * 64 + fr, col0 = u.pn * 128 + wc * 32 + 8 * fq;
#pragma unroll
        for (int ai = 0; ai < 2; ++ai)
#pragma unroll
            for (int m = 0; m < 4; ++m) { const int row = row0 + ai * 128 + m * 16; const float r = rs_of(ss, row);
                f32x4 h[2];
#pragma unroll
                for (int n = 0; n < 2; ++n) { const f32x4 g = acc[ai][0][m][n] * r, up = acc[ai][1][m][n] * r;
#pragma unroll
                    for (int e = 0; e < 4; ++e) h[n][e] = siluf_(g[e]) * up[e]; }
                *(u32x4*)(H + (size_t)row * FF + col0) = pack8(h[0], h[1]); }
    }
};
struct EpiResid {
    static constexpr bool PERM = true;
    const float* xin; float* xout; bf16* xb; float* ssout; float alpha;
    __device__ __forceinline__ void operator()(acc_t& acc, const Unit& u, int wr, int wc, int fr, int fq, int, int) const {
        const int row0 = u.pm * 256 + wr * 64 + fr, col0 = u.pn * 256 + wc * 32 + 8 * fq;
#pragma unroll
        for (int ai = 0; ai < 2; ++ai)
#pragma unroll
            for (int m = 0; m < 4; ++m) { const int row = row0 + ai * 128 + m * 16; float part = 0.f;
#pragma unroll
                for (int bj = 0; bj < 2; ++bj) { const size_t off = (size_t)row * D + col0 + bj * 128;
                    const f32x4 a0 = *(const f32x4*)(xin + off), a1 = *(const f32x4*)(xin + off + 4);
                    const f32x4 o0 = a0 + acc[ai][bj][m][0] * alpha, o1 = a1 + acc[ai][bj][m][1] * alpha;
                    *(f32x4*)(xout + off) = o0; *(f32x4*)(xout + off + 4) = o1;
                    *(u32x4*)(xb + off) = pack8(o0, o1);
                    part += (o0[0] * o0[0] + o0[1] * o0[1]) + (o0[2] * o0[2] + o0[3] * o0[3]) + (o1[0] * o1[0] + o1[1] * o1[1]) + (o1[2] * o1[2] + o1[3] * o1[3]); }
                part += __shfl_xor(part, 16); part += __shfl_xor(part, 32);
                if (ssout && fq == 0) atomicAdd(ssout + row, part); }
    }
};
struct EpiPlain {
    static constexpr bool PERM = true;
    bf16* O; int ldc; const float* ss; float cs;
    __device__ __forceinline__ void operator()(acc_t& acc, const Unit& u, int wr, int wc, int fr, int fq, int, int) const {
        const int row0 = u.pm * 256 + wr * 64 + fr, col0 = u.pn * 256 + wc * 32 + 8 * fq;
#pragma unroll
        for (int ai = 0; ai < 2; ++ai)
#pragma unroll
            for (int m = 0; m < 4; ++m) { const int row = row0 + ai * 128 + m * 16; const float r = (ss ? rs_of(ss, row) : 1.0f) * cs;
#pragma unroll
                for (int bj = 0; bj < 2; ++bj) *(u32x4*)(O + (size_t)row * ldc + col0 + bj * 128) = pack8(acc[ai][bj][m][0] * r, acc[ai][bj][m][1] * r); }
    }
};
struct EpiWin {
    static constexpr bool PERM = true;
    const float* ss; const float* lbraw; bf16* hq; float* logf; bf16* hi; bf16* hsg; bf16* sbq; bf16* sbk; bf16* sbv;
    __device__ __forceinline__ void operator()(acc_t& acc, const Unit& u, int wr, int wc, int fr, int fq, int, int) const {
        const int row0 = u.pm * 256 + wr * 64 + fr; const int seg = u.pn >> 1; const int cseg0 = (u.pn & 1) * 256 + wc * 32 + 8 * fq;
        if (seg == 1) {
            float lb[2][8];
#pragma unroll
            for (int bj = 0; bj < 2; ++bj)
#pragma unroll
                for (int e = 0; e < 8; ++e) { const int c = cseg0 + bj * 128 + e; lb[bj][e] = rcpf_(1.0f + ex2((lbraw[HGW + c] - lbraw[c]) * LOG2E)); }
#pragma unroll
            for (int ai = 0; ai < 2; ++ai)
#pragma unroll
                for (int m = 0; m < 4; ++m) { const int row = row0 + ai * 128 + m * 16; const float r = rs_of(ss, row);
#pragma unroll
                    for (int bj = 0; bj < 2; ++bj) { f32x4 o[2];
#pragma unroll
                        for (int n = 0; n < 2; ++n)
#pragma unroll
                            for (int e = 0; e < 4; ++e) { const float v = acc[ai][bj][m][n][e] * r; const float l = lb[bj][4 * n + e]; const float f = l + (1.0f - l) * sigmoidf_(v); o[n][e] = lg2(f) * LN2; }
                        float* p = logf + (size_t)row * HGW + cseg0 + bj * 128; *(f32x4*)p = o[0]; *(f32x4*)(p + 4) = o[1]; } }
            return;
        }
#pragma unroll
        for (int ai = 0; ai < 2; ++ai)
#pragma unroll
            for (int m = 0; m < 4; ++m) { const int row = row0 + ai * 128 + m * 16; const float r = rs_of(ss, row);
#pragma unroll
                for (int bj = 0; bj < 2; ++bj) { f32x4 v0 = acc[ai][bj][m][0] * r, v1 = acc[ai][bj][m][1] * r; const int cs = cseg0 + bj * 128;
                    bf16* dst;
                    if (seg == 0) dst = hq + (size_t)row * HGW + cs;
                    else if (seg == 2) dst = hi + (size_t)row * HGW + cs;
                    else if (seg == 3) { dst = hsg + (size_t)row * HGW + cs;
#pragma unroll
                        for (int e = 0; e < 4; ++e) { v0[e] = siluf_(v0[e]); v1[e] = siluf_(v1[e]); } }
                    else { const int b = row >> 13, s = row & (SEQ - 1), head = cs >> 6, d = cs & 63; const size_t o = ((size_t)(b * SBH + head) * SEQ + s) * SBD + d;
                        if (seg == 4) { dst = sbq + o; v0 = v0 * SB_QSCALE; v1 = v1 * SB_QSCALE; } else if (seg == 5) dst = sbk + o; else dst = sbv + o; }
                    *(u32x4*)dst = pack8(v0, v1); } }
    }
};
struct EpiSoftmax {
    static constexpr bool PERM = true;
    bf16* P; PG8_LAS unsigned char* xl;
    __device__ __forceinline__ void operator()(acc_t& acc, const Unit& u, int wr, int wc, int fr, int fq, int, int) const {
        typedef float f32x2v __attribute__((ext_vector_type(2)));
        PG8_LAS f32x2v* X = (PG8_LAS f32x2v*)xl;
        float mw[2][4];
#pragma unroll
        for (int ai = 0; ai < 2; ++ai)
#pragma unroll
            for (int m = 0; m < 4; ++m) { float mx = -3.0e38f;
#pragma unroll
                for (int bj = 0; bj < 2; ++bj)
#pragma unroll
                    for (int n = 0; n < 2; ++n) { const f32x4 v = acc[ai][bj][m][n]; mx = fmaxf(fmaxf(fmaxf(mx, v[0]), fmaxf(v[1], v[2])), v[3]); }
                mx = fmaxf(mx, __shfl_xor(mx, 16)); mx = fmaxf(mx, __shfl_xor(mx, 32));
                float s = 0.f;
#pragma unroll
                for (int bj = 0; bj < 2; ++bj)
#pragma unroll
                    for (int n = 0; n < 2; ++n) { f32x4 v = acc[ai][bj][m][n];
#pragma unroll
                        for (int e = 0; e < 4; ++e) { v[e] = ex2(v[e] - mx); s += v[e]; }
                        acc[ai][bj][m][n] = v; }
                s += __shfl_xor(s, 16); s += __shfl_xor(s, 32);
                if (fq == 0) X[(ai * 128 + wr * 64 + m * 16 + fr) * 4 + wc] = (f32x2v){mx, s};
                mw[ai][m] = mx; }
        asm volatile("s_waitcnt lgkmcnt(0)" ::: "memory"); __builtin_amdgcn_s_barrier(); asm volatile("" ::: "memory");
        const int row0 = u.pm * 256 + wr * 64 + fr, col0 = u.pn * 256 + wc * 32 + 8 * fq;
#pragma unroll
        for (int ai = 0; ai < 2; ++ai)
#pragma unroll
            for (int m = 0; m < 4; ++m) { const int rl = ai * 128 + wr * 64 + m * 16 + fr;
                const f32x2v a = X[rl * 4 + 0], b = X[rl * 4 + 1], c = X[rl * 4 + 2], d = X[rl * 4 + 3];
                const float mt = fmaxf(fmaxf(a.x, b.x), fmaxf(c.x, d.x));
                const float tot = a.y * ex2(a.x - mt) + b.y * ex2(b.x - mt) + c.y * ex2(c.x - mt) + d.y * ex2(d.x - mt);
                const float f = ex2(mw[ai][m] - mt) * rcpf_(tot);
                const int row = row0 + ai * 128 + m * 16;
#pragma unroll
                for (int bj = 0; bj < 2; ++bj) *(u32x4*)(P + (size_t)row * D + col0 + bj * 128) = pack8(acc[ai][bj][m][0] * f, acc[ai][bj][m][1] * f); }
    }
};

struct CrossOrder {
    const char* A; const char* B; int G, c, mode;
    __device__ __forceinline__ bool next(int i, Unit& u) const {
        const int L = i * G + c; if (L >= 512) return false;
        u.pm = L >> 2; u.pn = L & 3; const int b = u.pm >> 5;
        u.a = A + ((size_t)u.pm * 256 * D + u.pn * 256) * 2;
        u.b = mode == 0 ? B + ((size_t)b * 256 * D + u.pn * 256) * 2 : B + ((size_t)u.pn * 256 * D + b * 256) * 2;
        return true;
    }
};
struct OneUnit {
    const char* a; const char* b; int pm, pn;
    __device__ __forceinline__ bool next(int i, Unit& u) const { if (i > 0) return false; u.pm = pm; u.pn = pn; u.a = a; u.b = b; return true; }
};

struct Args { const float* in[20]; float* out; unsigned char* ws; int ph_lo, ph_hi; };

__device__ __forceinline__ void transpose_item(const float* W, int K, int N, bf16* WT, const float* gain, int mode, LAS float* scr, int item, int lane) {
    const int nblk = N / 32, kb = item / nblk, nb = item % nblk, k0 = 64 * kb, n0 = 32 * nb;
#pragma unroll 8
    for (int i = 0; i < 32; ++i) { const int kk = 2 * i + (lane >> 5); const float g = gain ? gain[k0 + kk] : 1.0f; scr[kk * 33 + (lane & 31)] = W[(size_t)(k0 + kk) * N + n0 + (lane & 31)] * g; }
    LDS_WAIT(); asm volatile("" ::: "memory");
    int orow0 = n0;
    if (mode == 1) { const int j = n0 < FF ? n0 : n0 - FF; orow0 = (j >> 7) * 256 + (n0 < FF ? 0 : 128) + (j & 127); }
    const int c = lane & 7;
#pragma unroll
    for (int j = 0; j < 4; ++j) { const int n = (lane >> 3) + 8 * j; const LAS float* s = scr + (8 * c) * 33 + n;
        v4u o; o.x = pk2(s[0 * 33], s[1 * 33]); o.y = pk2(s[2 * 33], s[3 * 33]); o.z = pk2(s[4 * 33], s[5 * 33]); o.w = pk2(s[6 * 33], s[7 * 33]);
        *(GAS v4u*)(WT + (size_t)(orow0 + n) * K + k0 + 8 * c) = o; }
    LDS_WAIT(); asm volatile("" ::: "memory");
}

__global__ void __launch_bounds__(NWAVES * 64, 2) layer_fwd(Args args) {
    extern __shared__ __attribute__((aligned(16))) unsigned char lds_raw[];
    LAS unsigned char* lds = (LAS unsigned char*)lds_raw;
    volatile LAS unsigned* MISC = (volatile LAS unsigned*)(lds + MISC_OFF);
    const int tid = threadIdx.x, lane = tid & 63, wave = __builtin_amdgcn_readfirstlane(tid >> 6);
    const int G = gridDim.x, bx = blockIdx.x;
    const int vcu = (G % 8 == 0) ? (bx % 8) * (G / 8) + bx / 8 : bx;
    unsigned char* ws = args.ws;
    gu32* ctl = (gu32*)(ws + WS_CTL);
    float* ss0 = (float*)(ws + WS_SS); float* ss1 = ss0 + M; float* ss2 = ss1 + M; float* ss3 = ss2 + M;
    bf16* Wgu1 = (bf16*)(ws + WS_WGU1); bf16* Wd1 = (bf16*)(ws + WS_WD1); bf16* Win = (bf16*)(ws + WS_WIN); bf16* Wout = (bf16*)(ws + WS_WOUT);
    bf16* Wq = (bf16*)(ws + WS_WQ); bf16* Wkv = (bf16*)(ws + WS_WKV); bf16* Wo = (bf16*)(ws + WS_WO); bf16* Wgu2 = (bf16*)(ws + WS_WGU2); bf16* Wd2 = (bf16*)(ws + WS_WD2);
    bf16* MN = (bf16*)(ws + WS_MN); bf16* KMEM = (bf16*)(ws + WS_KMEM); bf16* VT = (bf16*)(ws + WS_VT);
    bf16* XB = (bf16*)(ws + WS_XB); bf16* HMID = (bf16*)(ws + WS_HMID);
    bf16* HQ = (bf16*)(ws + WS_HQ); float* LOGF = (float*)(ws + WS_LOGF); bf16* HI = (bf16*)(ws + WS_HI); bf16* HSG = (bf16*)(ws + WS_HSG);
    bf16* SBQ = (bf16*)(ws + WS_SBQ); bf16* SBK = (bf16*)(ws + WS_SBK); bf16* SBV = (bf16*)(ws + WS_SBV);
    bf16* MIXED = (bf16*)(ws + WS_MIXED); bf16* QC = (bf16*)(ws + WS_QC); bf16* PMb = (bf16*)(ws + WS_PM); bf16* OC = (bf16*)(ws + WS_OC);
    const float* x_in = args.in[0]; float* out = args.out;

    for (int u = tid; u < (LDS_BYTES - LDSCTL_OFF) / 4; u += NWAVES * 64) ((LAS unsigned*)(lds + LDSCTL_OFF))[u] = 0u;
    __syncthreads();
#if MK_ONE_LAUNCH
    XcdBarrier bar = xcd_barrier_post((unsigned*)(ctl + CW_BAR), MISC + 8);
#define GRID_BAR() xcd_barrier(bar)
#else
#define GRID_BAR() do { } while (0)
#endif
    const int lo = args.ph_lo, hi = args.ph_hi;
#define IN(k) (lo <= (k) && (k) < hi)
#define SEAM(k) do { if (IN(k) && IN((k) + 1)) GRID_BAR(); } while (0)
    const int gw = vcu * NWAVES + wave, NGW = G * NWAVES;

    if (IN(0)) {
        LAS float* scr = (LAS float*)(lds + wave * 16384);
        constexpr int I_GU = (D / 64) * (GU / 32), I_DN = (FF / 64) * (D / 32), I_IN = (D / 64) * (INC / 32), I_SQ = (D / 64) * (D / 32), I_KV = (D / 64) * (2 * D / 32);
        constexpr int NITEMS = 2 * I_GU + 2 * I_DN + I_IN + 3 * I_SQ + I_KV;
        for (int it = gw; it < NITEMS; it += NGW) {
            int r = it;
            if (r < I_GU) { transpose_item(args.in[3], D, GU, Wgu1, args.in[2], 1, scr, r, lane); continue; } r -= I_GU;
            if (r < I_GU) { transpose_item(args.in[17], D, GU, Wgu2, args.in[16], 1, scr, r, lane); continue; } r -= I_GU;
            if (r < I_DN) { transpose_item(args.in[4], FF, D, Wd1, nullptr, 0, scr, r, lane); continue; } r -= I_DN;
            if (r < I_DN) { transpose_item(args.in[18], FF, D, Wd2, nullptr, 0, scr, r, lane); continue; } r -= I_DN;
            if (r < I_IN) { transpose_item(args.in[6], D, INC, Win, args.in[5], 0, scr, r, lane); continue; } r -= I_IN;
            if (r < I_SQ) { transpose_item(args.in[10], D, D, Wout, nullptr, 0, scr, r, lane); continue; } r -= I_SQ;
            if (r < I_SQ) { transpose_item(args.in[13], D, D, Wq, args.in[11], 0, scr, r, lane); continue; } r -= I_SQ;
            if (r < I_SQ) { transpose_item(args.in[15], D, D, Wo, nullptr, 0, scr, r, lane); continue; } r -= I_SQ;
            transpose_item(args.in[14], D, 2 * D, Wkv, nullptr, 0, scr, r, lane);
        }
        for (int m = gw; m < M; m += NGW) {
            const GAS f32x4* xr = (const GAS f32x4*)(x_in + (size_t)m * D) + lane; f32x4 v[4]; float s = 0.f;
#pragma unroll
            for (int j = 0; j < 4; ++j) { v[j] = xr[64 * j]; s += (v[j].x * v[j].x + v[j].y * v[j].y) + (v[j].z * v[j].z + v[j].w * v[j].w); }
            s = wave_sum(s);
            GAS unsigned long long* o8 = (GAS unsigned long long*)(XB + (size_t)m * D) + lane;
#pragma unroll
            for (int j = 0; j < 4; ++j) o8[64 * j] = (unsigned long long)pk2(v[j].x, v[j].y) | ((unsigned long long)pk2(v[j].z, v[j].w) << 32);
            if (lane == 0) ss0[m] = s;
        }
        for (int m = gw; m < MROWS; m += NGW) {
            const GAS f32x4* xr = (const GAS f32x4*)(args.in[1] + (size_t)m * D) + lane; const GAS f32x4* gr = (const GAS f32x4*)(args.in[12]) + lane; f32x4 v[4]; float s = 0.f;
#pragma unroll
            for (int j = 0; j < 4; ++j) { v[j] = xr[64 * j]; s += (v[j].x * v[j].x + v[j].y * v[j].y) + (v[j].z * v[j].z + v[j].w * v[j].w); }
            const float r = __builtin_amdgcn_rsqf(wave_sum(s) * (1.0f / (float)D) + EPS);
            GAS unsigned long long* o8 = (GAS unsigned long long*)(MN + (size_t)m * D) + lane;
#pragma unroll
            for (int j = 0; j < 4; ++j) { const f32x4 g = gr[64 * j]; o8[64 * j] = (unsigned long long)pk2(v[j].x * r * g.x, v[j].y * r * g.y) | ((unsigned long long)pk2(v[j].z * r * g.z, v[j].w * r * g.w) << 32); }
        }
    }
    SEAM(0);
    if (IN(1)) { pg8::TileOrder S; S.init(XB, Wgu1, D, D, M, GU, G, bx); EpiSwiglu E{HMID, ss0}; pg8::gemm_phase(lds, D, D, D, S, E); }
    SEAM(1);
    if (IN(2)) { pg8::TileOrder S; S.init(HMID, Wd1, FF, FF, M, D, G, bx); EpiResid E{x_in, out, XB, ss1, 0.5f}; pg8::gemm_phase(lds, FF, FF, FF, S, E); }
    SEAM(2);
    if (IN(3)) { pg8::TileOrder S; S.init(XB, Win, D, D, M, INC, G, bx); EpiWin E{ss1, args.in[7], HQ, LOGF, HI, HSG, SBQ, SBK, SBV}; pg8::gemm_phase(lds, D, D, D, S, E); }
    SEAM(3);
    if (IN(4)) {
        if (bx < 16) {
            const int b = bx >> 2, h = bx & 3, dq = tid & 3, dv = tid >> 2;
            LAS float* Fs = (LAS float*)lds; LAS float* Qs = Fs + 8192; LAS float* Is = Qs + 8192; LAS float* Os = Is + 8192;
            float St[32];
#pragma unroll
            for (int j = 0; j < 32; ++j) St[j] = 0.f;
            const float* ghg = args.in[8];
            for (int t0 = 0; t0 < SEQ; t0 += 64) {
                const size_t rbase = (size_t)b * SEQ + t0;
#pragma unroll 4
                for (int i = 0; i < 16; ++i) { const int idx = tid + 512 * i, r = idx >> 7, c = idx & 127; const size_t g = (rbase + r) * HGW + h * HGD + c;
                    Fs[idx] = ex2(LOGF[g] * LOG2E); Qs[idx] = bf2f(HQ[g]); Is[idx] = bf2f(HI[g]); }
                __syncthreads();
                for (int tt = 0; tt < 64; ++tt) {
                    const float iv = Is[tt * 128 + dv]; float o = 0.f;
#pragma unroll
                    for (int j4 = 0; j4 < 8; ++j4) { const f32x4 f4 = *(const LAS f32x4*)(Fs + tt * 128 + dq * 32 + j4 * 4), q4 = *(const LAS f32x4*)(Qs + tt * 128 + dq * 32 + j4 * 4);
#pragma unroll
                        for (int e = 0; e < 4; ++e) { float s = St[j4 * 4 + e]; s = iv + f4[e] * (s - iv); St[j4 * 4 + e] = s; o += s * q4[e]; } }
                    o += __shfl_xor(o, 1); o += __shfl_xor(o, 2);
                    if (dq == 0) Os[tt * 128 + dv] = o;
                }
                __syncthreads();
                for (int k = 0; k < 8; ++k) { const int tt = wave * 8 + k; const float v0 = Os[tt * 128 + lane], v1 = Os[tt * 128 + 64 + lane];
                    const float r = __builtin_amdgcn_rsqf(wave_sum(v0 * v0 + v1 * v1) * (1.0f / (float)HGD) + EPS);
                    const size_t row = rbase + tt; const int c0 = h * HGD + lane, c1 = c0 + 64;
                    MIXED[row * D + c0] = (bf16)f2bf(v0 * r * ghg[c0] * bf2f(HSG[row * HGW + c0]));
                    MIXED[row * D + c1] = (bf16)f2bf(v1 * r * ghg[c1] * bf2f(HSG[row * HGW + c1])); }
                __syncthreads();
            }
        } else if (bx < 32) {
            const int L = bx - 16; OneUnit S{(const char*)(MN + (size_t)(L >> 2) * 256 * D), (const char*)(Wkv + (size_t)(L & 3) * 256 * D), L >> 2, L & 3};
            EpiPlain E{KMEM, D, nullptr, 1.0f}; pg8::gemm_phase(lds, D, D, D, S, E);
        } else if (bx < 48) {
            const int L = bx - 32; OneUnit S{(const char*)(Wkv + (size_t)(D + (L >> 2) * 256) * D), (const char*)(MN + (size_t)(L & 3) * 256 * D), L >> 2, L & 3};
            EpiPlain E{VT, D, nullptr, 1.0f}; pg8::gemm_phase(lds, D, D, D, S, E);
        } else {
            const int sw = (bx - 48) * NWAVES + wave, nsw = (G - 48) * NWAVES; const float* gsb = args.in[9];
            for (int R = sw; R < BATCH * SBH * SEQ; R += nsw) {
                const int t = R & (SEQ - 1), bh = R >> 13, h = bh & 7, b = bh >> 3;
                const bf16* kbase = SBK + (size_t)bh * SEQ * SBD; const bf16* vbase = SBV + (size_t)bh * SEQ * SBD;
                const float qf = bf2f(SBQ[(size_t)R * SBD + lane]);
                float o = 0.f, carry = 0.f;
                if (t > 0) for (int tile = (t - 1) >> 6; tile >= 0; --tile) {
                    const int s = tile * 64 + lane; const bool valid = s < t;
                    const v4u* kr = (const v4u*)(kbase + (size_t)s * SBD); float z = 0.f;
#pragma unroll
                    for (int c8 = 0; c8 < 8; ++c8) { const v4u kv = kr[c8];
                        z += rdlane(qf, c8 * 8 + 0) * bf_lo(kv.x) + rdlane(qf, c8 * 8 + 1) * bf_hi(kv.x) + rdlane(qf, c8 * 8 + 2) * bf_lo(kv.y) + rdlane(qf, c8 * 8 + 3) * bf_hi(kv.y)
                           + rdlane(qf, c8 * 8 + 4) * bf_lo(kv.z) + rdlane(qf, c8 * 8 + 5) * bf_hi(kv.z) + rdlane(qf, c8 * 8 + 6) * bf_lo(kv.w) + rdlane(qf, c8 * 8 + 7) * bf_hi(kv.w); }
                    const float sp = valid ? fmaxf(z, 0.f) + lg2(1.0f + ex2(-fabsf(z))) : 0.f;
                    float suf = sp;
#pragma unroll
                    for (int off = 1; off < 64; off <<= 1) { const float v = __shfl_down(suf, off); if (lane + off < 64) suf += v; }
                    const float w = valid ? ex2(z - (carry + suf)) : 0.f;
                    const bf16* vt = vbase + (size_t)tile * 64 * SBD + lane;
#pragma unroll 8
                    for (int j = 0; j < 64; ++j) o += rdlane(w, j) * bf2f(vt[j * SBD]);
                    carry += rdlane(suf, 0);
                    if (carry > SB_STOP) break;
                }
                const float r = __builtin_amdgcn_rsqf(wave_sum(o * o) * (1.0f / (float)SBD) + EPS);
                MIXED[((size_t)b * SEQ + t) * D + HGW + h * SBD + lane] = (bf16)f2bf(o * r * gsb[h * SBD + lane]);
            }
        }
    }
    SEAM(4);
    if (IN(5)) { pg8::TileOrder S; S.init(MIXED, Wout, D, D, M, D, G, bx); EpiResid E{out, out, XB, ss2, 1.0f}; pg8::gemm_phase(lds, D, D, D, S, E); }
    SEAM(5);
    if (IN(6)) { pg8::TileOrder S; S.init(XB, Wq, D, D, M, D, G, bx); EpiPlain E{QC, D, ss2, CA_QSCALE}; pg8::gemm_phase(lds, D, D, D, S, E); }
    SEAM(6);
    if (IN(7)) { CrossOrder S{(const char*)QC, (const char*)KMEM, G, bx, 0}; EpiSoftmax E{PMb, lds + EPI_OFF}; int kc = CHD; asm volatile("" : "+s"(kc)); pg8::gemm_phase(lds, kc, D, D, S, E); }
    SEAM(7);
    if (IN(8)) { CrossOrder S{(const char*)PMb, (const char*)VT, G, bx, 1}; EpiPlain E{OC, D, nullptr, 1.0f}; int kc = NMEM; asm volatile("" : "+s"(kc)); pg8::gemm_phase(lds, kc, D, D, S, E); }
    SEAM(8);
    if (IN(9)) { pg8::TileOrder S; S.init(OC, Wo, D, D, M, D, G, bx); EpiResid E{out, out, XB, ss3, 1.0f}; pg8::gemm_phase(lds, D, D, D, S, E); }
    SEAM(9);
    if (IN(10)) { pg8::TileOrder S; S.init(XB, Wgu2, D, D, M, GU, G, bx); EpiSwiglu E{HMID, ss3}; pg8::gemm_phase(lds, D, D, D, S, E); }
    SEAM(10);
    if (IN(11)) { pg8::TileOrder S; S.init(HMID, Wd2, FF, FF, M, D, G, bx); EpiResid E{out, out, XB, nullptr, 0.5f}; pg8::gemm_phase(lds, FF, FF, FF, S, E); }
    SEAM(11);
    if (IN(12)) {
        const GAS f32x4* gr = (const GAS f32x4*)(args.in[19]) + lane;
        for (int m = gw; m < M; m += NGW) {
            GAS f32x4* xr = (GAS f32x4*)(out + (size_t)m * D) + lane; f32x4 v[4]; float s = 0.f;
#pragma unroll
            for (int j = 0; j < 4; ++j) { v[j] = xr[64 * j]; s += (v[j].x * v[j].x + v[j].y * v[j].y) + (v[j].z * v[j].z + v[j].w * v[j].w); }
            const float r = __builtin_amdgcn_rsqf(wave_sum(s) * (1.0f / (float)D) + EPS);
#pragma unroll
            for (int j = 0; j < 4; ++j) { const f32x4 g = gr[64 * j]; xr[64 * j] = v[j] * r * g; }
        }
    }
#undef IN
#undef SEAM
}

constexpr int N_PHASES = 13;
extern "C" void kernel_launch(void* const* d_in, const int* in_sizes, int n_in, void* d_out, int out_size, void* d_ws, size_t ws_size, hipStream_t stream) {
    static int grid = 0;
    if (grid == 0) {
        if (n_in != 20 || in_sizes[0] != M * D || out_size != M * D || ws_size < WS_END) { fprintf(stderr, "kernel_launch: unexpected shapes (n_in %d, in0 %d, out %d, ws %zu)\n", n_in, n_in > 0 ? in_sizes[0] : -1, out_size, ws_size); grid = -1; return; }
        int dev = 0, cus = 0;
        if (hipGetDevice(&dev) != hipSuccess || hipDeviceGetAttribute(&cus, hipDeviceAttributeMultiprocessorCount, dev) != hipSuccess) { grid = -1; return; }
        if (hipFuncSetAttribute((const void*)layer_fwd, hipFuncAttributeMaxDynamicSharedMemorySize, LDS_BYTES) != hipSuccess) { fprintf(stderr, "kernel_launch: hipFuncSetAttribute failed\n"); grid = -1; return; }
        int per_cu = 0;
        if (hipOccupancyMaxActiveBlocksPerMultiprocessor(&per_cu, (const void*)layer_fwd, NWAVES * 64, LDS_BYTES) != hipSuccess || per_cu < 1) fprintf(stderr, "kernel_launch: occupancy query says %d\n", per_cu);
        (void)hipGetLastError();
        grid = cus;
    }
    if (grid < 0) return;
    if (hipMemsetAsync((char*)d_ws + WS_CTL, 0, CTL_ZERO_BYTES, stream) != hipSuccess) return;
    Args a{};
    for (int i = 0; i < 20; ++i) a.in[i] = (const float*)d_in[i];
    a.out = (float*)d_out; a.ws = (unsigned char*)d_ws;
#if MK_ONE_LAUNCH
    a.ph_lo = 0; a.ph_hi = N_PHASES;
    hipLaunchKernelGGL(layer_fwd, dim3(grid), dim3(NWAVES * 64), LDS_BYTES, stream, a);
#else
    for (int p = 0; p < N_PHASES; ++p) { a.ph_lo = p; a.ph_hi = p + 1; hipLaunchKernelGGL(layer_fwd, dim3(grid), dim3(NWAVES * 64), LDS_BYTES, stream, a); }
#endif
}
```

```cpp
#include <hip/hip_runtime.h>
#include <cstdio>
#include <cstdint>

#ifndef MK_ONE_LAUNCH
#define MK_ONE_LAUNCH 1
#endif

namespace pg8 {
#define PG8_LAS __attribute__((address_space(3)))
typedef unsigned short bf16_t;
typedef short bf16x8 __attribute__((ext_vector_type(8)));
typedef float f32x4 __attribute__((ext_vector_type(4)));
typedef float f32x2 __attribute__((ext_vector_type(2)));
typedef unsigned u32x4 __attribute__((ext_vector_type(4)));
constexpr int BM = 256, BK = 64, HALF = 128, HTB = HALF * BK * 2, STAGE_BYTES = 8 * HTB, NXCD = 8, WGM = 8;

__host__ __device__ __forceinline__ int lds_byte(int r, int c) { const int st = (r >> 4) * 2 + (c >> 5), rr = r & 15, cc = c & 31, ob = rr * 64 + cc * 2; return st * 1024 + (ob ^ (((ob >> 9) & 1) << 5)); }
__host__ __device__ __forceinline__ void stage_rc(int b, int& R, int& C) { const int st = b / 1024, sb = b % 1024, swz = sb ^ (((sb >> 9) & 1) << 5); R = (st >> 1) * 16 + swz / 64; C = (st & 1) * 32 + (swz % 64) / 2; }
__host__ __device__ __forceinline__ int perm32(int rho) { const int n = rho >> 4, i = rho & 15; return 8 * (i >> 2) + 4 * n + (i & 3); }

struct Unit { int pm, pn; const char* a; const char* b; };

__device__ __forceinline__ unsigned cvt_pk_bf16(float lo, float hi) { unsigned r; asm volatile("v_cvt_pk_bf16_f32 %0, %1, %2" : "=v"(r) : "v"(lo), "v"(hi)); return r; }

struct TileOrder {
    const char* A; const char* B; int lda, ldb; int nM, nN, nwg, G, c;
    __device__ __forceinline__ void init(const void* A_, const void* B_, int lda_, int ldb_, int M, int N, int G_, int c_) { A = (const char*)A_; B = (const char*)B_; lda = lda_; ldb = ldb_; nM = M / BM; nN = N / BM; nwg = nM * nN; G = G_; c = c_; }
    __device__ __forceinline__ bool next(int i, Unit& u) const {
        const long L = (long)i * G + c; if (L >= nwg) return false;
        int wgid = (int)L; { const int q = nwg / NXCD, r = nwg % NXCD, xcd = wgid % NXCD, off = wgid / NXCD; wgid = (xcd < r ? xcd * (q + 1) : r * (q + 1) + (xcd - r) * q) + off; }
        const int nig = WGM * nN, gid = wgid / nig, fm = gid * WGM, gsz = (nM - fm) < WGM ? (nM - fm) : WGM;
        u.pm = fm + ((wgid % nig) % gsz); u.pn = (wgid % nig) / gsz;
        u.a = A + (size_t)u.pm * BM * lda * 2; u.b = B + (size_t)u.pn * BM * ldb * 2; return true;
    }
};

template <class Epi, class Sched>
__device__ __forceinline__ void gemm_phase(PG8_LAS unsigned char* lds, const int K, const int lda, const int ldb, const Sched& S, const Epi& E) {
    const int tid = threadIdx.x, wid = __builtin_amdgcn_readfirstlane(tid >> 6), lane = tid & 63, wr = wid >> 2, wc = wid & 3, fr = lane & 15, fq = lane >> 4;
    const int nt = K / BK;
    unsigned voffA[2], voffB[2];
#pragma unroll
    for (int i = 0; i < 2; ++i) { int R, C; stage_rc(tid * 16 + i * 8192, R, C); const int Rb = Epi::PERM ? ((R & ~31) + perm32(R & 31)) : R;
        voffA[i] = (unsigned)(R * lda + C) * 2u; voffB[i] = (unsigned)(Rb * ldb + C) * 2u; }
    const size_t kstep = (size_t)(BK * 2);
    const size_t hstepA = (size_t)HALF * lda * 2, hstepB = (size_t)HALF * ldb * 2;
    const unsigned ldsw = (unsigned)wid * 1024u;
    const int aoff = lds_byte(wr * 64 + fr, fq * 8), boff = lds_byte(wc * 32 + fr, fq * 8);
#define PG8_SA(b, h) (((b) * 2 + (h)) * HTB)
#define PG8_SB(b, h) ((4 + (b) * 2 + (h)) * HTB)
#define PG8_STAGE(bufoff, gbase, voff) do { _Pragma("unroll") for (int _i = 0; _i < 2; ++_i) \
        __builtin_amdgcn_global_load_lds((const unsigned*)((const char*)(gbase) + (voff)[_i]), (PG8_LAS unsigned*)(lds + (bufoff) + ldsw + _i * 8192), 16, 0, 0); } while (0)
#define PG8_LDA(dst, b, h) do { _Pragma("unroll") for (int m = 0; m < 4; ++m) _Pragma("unroll") for (int k = 0; k < 2; ++k) dst[m][k] = *(const PG8_LAS bf16x8*)(lds + PG8_SA(b, h) + aoff + m * 2048 + k * 1024); } while (0)
#define PG8_LDB(dst, b, h) do { _Pragma("unroll") for (int n = 0; n < 2; ++n) _Pragma("unroll") for (int k = 0; k < 2; ++k) dst[n][k] = *(const PG8_LAS bf16x8*)(lds + PG8_SB(b, h) + boff + n * 2048 + k * 1024); } while (0)
#define PG8_MMA(ai, bj, At, Bt) do { __builtin_amdgcn_s_setprio(1); _Pragma("unroll") for (int m = 0; m < 4; ++m) _Pragma("unroll") for (int n = 0; n < 2; ++n) _Pragma("unroll") for (int k = 0; k < 2; ++k) \
        acc[ai][bj][m][n] = __builtin_amdgcn_mfma_f32_16x16x32_bf16(Bt[n][k], At[m][k], acc[ai][bj][m][n], 0, 0, 0); __builtin_amdgcn_s_setprio(0); } while (0)
#define PG8_WAIT_V(n) asm volatile("s_waitcnt vmcnt(" #n ")" ::: "memory")
#define PG8_WAIT_L(n) asm volatile("s_waitcnt lgkmcnt(" #n ")" ::: "memory")
#define PG8_BAR __builtin_amdgcn_s_barrier()
#define PG8_SCHED __builtin_amdgcn_sched_barrier(0)
    Unit cur, nxt; int ui = 0;
    if (!S.next(0, cur)) return;
    f32x4 acc[2][2][4][2];
#pragma unroll
    for (int a = 0; a < 2; ++a)
#pragma unroll
        for (int b = 0; b < 2; ++b)
#pragma unroll
            for (int m = 0; m < 4; ++m)
#pragma unroll
                for (int n = 0; n < 2; ++n) acc[a][b][m][n] = (f32x4){0.f, 0.f, 0.f, 0.f};
    bf16x8 At[4][2], B0[2][2], B1[2][2];
    const char* cA = cur.a; const char* cB = cur.b;
    PG8_STAGE(PG8_SB(0, 0), cB, voffB); PG8_STAGE(PG8_SB(0, 1), cB + hstepB, voffB); PG8_STAGE(PG8_SA(0, 0), cA, voffA); PG8_STAGE(PG8_SA(0, 1), cA + hstepA, voffA);
    if (wr == 1) PG8_BAR;
    PG8_WAIT_V(2); PG8_BAR;
    PG8_STAGE(PG8_SB(1, 0), cB + kstep, voffB); PG8_STAGE(PG8_SA(1, 0), cA + kstep, voffA); PG8_STAGE(PG8_SB(1, 1), cB + hstepB + kstep, voffB);
    PG8_WAIT_V(6); PG8_BAR;
    for (;;) {
        const bool has_next = S.next(ui + 1, nxt);
        const char* nA = has_next ? nxt.a : cA; const char* nB = has_next ? nxt.b : cB;
        for (int t = 0; t < nt; t += 2) {
            const bool last = (t == nt - 2);
            const char* a1 = cA + (size_t)(t + 1) * kstep;
            const char* a2 = last ? nA : cA + (size_t)(t + 2) * kstep; const char* b2 = last ? nB : cB + (size_t)(t + 2) * kstep;
            const char* a3 = a2 + kstep; const char* b3 = b2 + kstep;
            PG8_LDB(B0, 0, 0); PG8_LDB(B1, 0, 1); PG8_SCHED; PG8_LDA(At, 0, 0); PG8_STAGE(PG8_SA(1, 1), a1 + hstepA, voffA);
            PG8_WAIT_V(8); PG8_WAIT_L(0); PG8_BAR; PG8_MMA(0, 0, At, B0); PG8_MMA(0, 1, At, B1); PG8_BAR; PG8_SCHED;
            PG8_LDA(At, 0, 1); PG8_STAGE(PG8_SB(0, 0), b2, voffB); PG8_STAGE(PG8_SB(0, 1), b2 + hstepB, voffB); PG8_STAGE(PG8_SA(0, 0), a2, voffA);
            PG8_WAIT_V(8); PG8_WAIT_L(0); PG8_BAR; PG8_MMA(1, 0, At, B0); PG8_MMA(1, 1, At, B1); PG8_BAR; PG8_SCHED;
            PG8_LDB(B0, 1, 0); PG8_LDB(B1, 1, 1); PG8_SCHED; PG8_LDA(At, 1, 0); PG8_STAGE(PG8_SA(0, 1), a2 + hstepA, voffA);
            PG8_WAIT_V(8); PG8_WAIT_L(0); PG8_BAR; PG8_MMA(0, 0, At, B0); PG8_MMA(0, 1, At, B1); PG8_BAR; PG8_SCHED;
            PG8_LDA(At, 1, 1); PG8_STAGE(PG8_SB(1, 0), b3, voffB); PG8_STAGE(PG8_SB(1, 1), b3 + hstepB, voffB); PG8_STAGE(PG8_SA(1, 0), a3, voffA);
            PG8_WAIT_V(8); PG8_WAIT_L(0); PG8_BAR; PG8_MMA(1, 0, At, B0); PG8_MMA(1, 1, At, B1); PG8_BAR; PG8_SCHED;
        }
        if (wr == 0) PG8_BAR;
        E(acc, cur, wr, wc, fr, fq, wid, lane);
        if (!has_next) break;
#pragma unroll
        for (int a = 0; a < 2; ++a)
#pragma unroll
            for (int b = 0; b < 2; ++b)
#pragma unroll
                for (int m = 0; m < 4; ++m)
#pragma unroll
                    for (int n = 0; n < 2; ++n) acc[a][b][m][n] = (f32x4){0.f, 0.f, 0.f, 0.f};
        cur = nxt; cA = nA; cB = nB; ++ui;
        if (wr == 1) PG8_BAR;
    }
    PG8_WAIT_V(0);
    PG8_BAR;
#undef PG8_SA
#undef PG8_SB
#undef PG8_STAGE
#undef PG8_LDA
#undef PG8_LDB
#undef PG8_MMA
#undef PG8_WAIT_V
#undef PG8_WAIT_L
#undef PG8_BAR
#undef PG8_SCHED
}
}

constexpr int NWAVES = 8;
constexpr int BATCH = 4, SEQ = 8192, D = 1024, M = BATCH * SEQ;
constexpr int FF = 2816, GU = 2 * FF, INC = 3584, NMEM = 256, MROWS = BATCH * NMEM;
constexpr int HGW = 512, HGH = 4, HGD = 128, SBW = 512, SBH = 8, SBD = 64, CHD = 256;
constexpr float EPS = 1e-6f, LOG2E = 1.4426950408889634f, LN2 = 0.6931471805599453f;
constexpr float SB_QSCALE = 0.125f * LOG2E;
constexpr float CA_QSCALE = 0.0625f * LOG2E;
constexpr float SB_STOP = 160.0f;

constexpr size_t MiB = 1u << 20;
constexpr size_t WS_CTL = 0, CTL_ZERO_BYTES = 2 * MiB;
constexpr size_t WS_SS = 1 * MiB;
constexpr size_t WS_WGU1 = 2 * MiB, WS_WD1 = 13 * MiB, WS_WIN = 19 * MiB, WS_WOUT = 26 * MiB, WS_WQ = 28 * MiB, WS_WKV = 30 * MiB, WS_WO = 34 * MiB, WS_WGU2 = 36 * MiB, WS_WD2 = 47 * MiB;
constexpr size_t WS_MN = 53 * MiB, WS_KMEM = 55 * MiB, WS_VT = 57 * MiB, WS_DVEC = 59 * MiB;
constexpr size_t WS_ST = 64 * MiB;
constexpr size_t WS_XB = 64 * MiB;
constexpr size_t WS_HMID = 128 * MiB;
constexpr size_t WS_HQ = 128 * MiB, WS_LOGF = 160 * MiB, WS_HI = 224 * MiB, WS_HSG = 256 * MiB;
constexpr size_t WS_SBQ = 304 * MiB, WS_SBK = 336 * MiB, WS_SBV = 368 * MiB;
constexpr size_t WS_MIXED = 400 * MiB;
constexpr size_t WS_QC = 128 * MiB, WS_PM = 192 * MiB, WS_OC = 304 * MiB;
constexpr size_t WS_END = 464 * MiB;
constexpr int CW_TMO = 0, CW_CODE = 1, CW_BAR = 4096;

constexpr int RING_BYTES = 131072;
constexpr int LDSCTL_OFF = RING_BYTES, MISC_OFF = LDSCTL_OFF + 320;
constexpr int EPI_OFF = RING_BYTES + 1024;
constexpr int LDS_BYTES = 147456;

#define GAS __attribute__((address_space(1)))
#define LAS __attribute__((address_space(3)))
typedef unsigned short bf16;
typedef unsigned v4u __attribute__((ext_vector_type(4)));
typedef float f32x4 __attribute__((ext_vector_type(4)));
typedef GAS unsigned gu32;
#define RLX_AGENT __ATOMIC_RELAXED, __HIP_MEMORY_SCOPE_AGENT
#define LDS_WAIT() asm volatile("s_waitcnt lgkmcnt(0)" ::: "memory")
#define VM_WAIT() asm volatile("s_waitcnt vmcnt(0)" ::: "memory")
__device__ __forceinline__ unsigned f2bf(float f) { unsigned u = __builtin_bit_cast(unsigned, f); return (u + 0x7fffu + ((u >> 16) & 1u)) >> 16; }
__device__ __forceinline__ unsigned pk2(float lo, float hi) { return f2bf(lo) | (f2bf(hi) << 16); }
__device__ __forceinline__ float bf_lo(unsigned w) { return __builtin_bit_cast(float, w << 16); }
__device__ __forceinline__ float bf_hi(unsigned w) { return __builtin_bit_cast(float, w & 0xffff0000u); }
__device__ __forceinline__ float bf2f(bf16 h) { return __builtin_bit_cast(float, (unsigned)h << 16); }
__device__ __forceinline__ float ex2(float x) { return __builtin_amdgcn_exp2f(x); }
__device__ __forceinline__ float lg2(float x) { return __builtin_amdgcn_logf(x); }
__device__ __forceinline__ float rcpf_(float x) { return __builtin_amdgcn_rcpf(x); }
__device__ __forceinline__ float sigmoidf_(float v) { return rcpf_(1.0f + ex2(-v * LOG2E)); }
__device__ __forceinline__ float siluf_(float v) { return v * sigmoidf_(v); }
__device__ __forceinline__ float rdlane(float v, int l) { return __builtin_bit_cast(float, __builtin_amdgcn_readlane(__builtin_bit_cast(int, v), l)); }
__device__ __forceinline__ float wave_sum(float v) {
#pragma unroll
    for (int o = 1; o < 64; o <<= 1) v += __shfl_xor(v, o);
    return v;
}

#define XB_TMO      128
#define XB_XCNT(j)  (256  + 64 * (j))
#define XB_XSUB(j)  (1280 + 64 * (j))
#define XB_XGEN(j)  (2304 + 64 * (j))
#define XB_TOP      3328
#define XB_TOPGEN   3392
#define XCD_BAR_WORDS 3456
#define XB_SPIN_CAP (1u << 18)
__device__ __forceinline__ unsigned xb_ld(unsigned* p)              { return __hip_atomic_load(p, __ATOMIC_RELAXED, __HIP_MEMORY_SCOPE_AGENT); }
__device__ __forceinline__ unsigned xb_add(unsigned* p, unsigned v) { return __hip_atomic_fetch_add(p, v, __ATOMIC_RELAXED, __HIP_MEMORY_SCOPE_AGENT); }
__device__ __forceinline__ unsigned xb_xcc_id() { return (unsigned)__builtin_amdgcn_s_getreg((3 << 11) | 20) & 0xFu; }
#define XB_SPIN(cond, bar) do { unsigned _sp = 0; while (cond) { __builtin_amdgcn_s_sleep(1); \
    if ((++_sp & 255u) == 0u) { if (xb_ld(&(bar)[XB_TMO])) break; if (_sp > XB_SPIN_CAP) { atomicAdd(&(bar)[XB_TMO], 1u); break; } } } } while (0)
struct XcdBarrier { unsigned* bar; unsigned x; volatile LAS unsigned* st; };
__device__ __forceinline__ XcdBarrier xcd_barrier_post(unsigned* bar, volatile LAS unsigned* st) {
    XcdBarrier b; b.bar = bar; b.x = xb_xcc_id(); b.st = st;
    if (threadIdx.x == 0) (void)xb_add(&bar[XB_XCNT(b.x)], 1u);
    return b;
}
__device__ __forceinline__ void xcd_barrier_complete(unsigned* bar, unsigned x, unsigned& nloc, unsigned& nx) {
    const unsigned G = gridDim.x * gridDim.y * gridDim.z;
    unsigned sum, cnt, mine, sp = 0u;
    for (;;) {
        sum = 0u; cnt = 0u; mine = 0u;
#pragma unroll
        for (unsigned j = 0; j < 16; ++j) { const unsigned c = xb_ld(&bar[XB_XCNT(j)]); sum += c; cnt += (c > 0u) ? 1u : 0u; mine = (j == x) ? c : mine; }
        if (sum == G) break;
        __builtin_amdgcn_s_sleep(1);
        if ((++sp & 255u) == 0u) { if (xb_ld(&bar[XB_TMO])) break; if (sp > XB_SPIN_CAP) { atomicAdd(&bar[XB_TMO], 1u); break; } }
    }
    nloc = mine > 0u ? mine : 1u; nx = cnt > 0u ? cnt : 1u;
}
__device__ __forceinline__ void xcd_barrier(const XcdBarrier& b) {
    asm volatile("s_waitcnt vmcnt(0)" ::: "memory");
    __syncthreads();
    if (threadIdx.x == 0) {
        unsigned* bar = b.bar;
        __builtin_amdgcn_s_waitcnt(0);
        unsigned nloc = b.st[0], nx = b.st[1];
        if (nloc == 0u) { xcd_barrier_complete(bar, b.x, nloc, nx); b.st[0] = nloc; b.st[1] = nx; }
        const unsigned old = xb_add(&bar[XB_XSUB(b.x)], 1u);
        const unsigned gen = old / nloc;
        if (old + 1u == (gen + 1u) * nloc) {
            __builtin_amdgcn_fence(__ATOMIC_RELEASE, "agent");
            asm volatile("s_waitcnt vmcnt(0)" ::: "memory");
            const unsigned og = xb_add(&bar[XB_TOP], 1u);
            const unsigned tg = og / nx;
            if (og + 1u == (tg + 1u) * nx) xb_add(&bar[XB_TOPGEN], 1u);
            else XB_SPIN(xb_ld(&bar[XB_TOPGEN]) == tg, bar);
            __builtin_amdgcn_fence(__ATOMIC_ACQUIRE, "agent");
            xb_add(&bar[XB_XGEN(b.x)], 1u);
            asm volatile("s_waitcnt vmcnt(0)" ::: "memory");
        } else {
            XB_SPIN(xb_ld(&bar[XB_XGEN(b.x)]) == gen, bar);
            __builtin_amdgcn_fence(__ATOMIC_ACQUIRE, "agent");
            asm volatile("s_waitcnt vmcnt(0)" ::: "memory");
        }
    }
    __syncthreads();
}

using pg8::f32x4; using pg8::u32x4; using pg8::Unit; using pg8::cvt_pk_bf16;
typedef f32x4 acc_t[2][2][4][2];
__device__ __forceinline__ float rs_of(const float* ss, int row) { return __builtin_amdgcn_rsqf(ss[row] * (1.0f / (float)D) + EPS); }
__device__ __forceinline__ u32x4 pack8(const f32x4 a, const f32x4 b) { u32x4 w; w.x = cvt_pk_bf16(a[0], a[1]); w.y = cvt_pk_bf16(a[2], a[3]); w.z = cvt_pk_bf16(b[0], b[1]); w.w = cvt_pk_bf16(b[2], b[3]); return w; }

struct EpiSwiglu {
    static constexpr bool PERM = true;
    bf16* H; const float* ss;
    __device__ __forceinline__ void operator()(acc_t& acc, const Unit& u, int wr, int wc, int fr, int fq, int, int) const {
        const int row0 = u.pm * 256 + wr * 64 + fr, col0 = u.pn * 128 + wc * 32 + 8 * fq;
#pragma unroll
        for (int ai = 0; ai < 2; ++ai)
#pragma unroll
            for (int m = 0; m < 4; ++m) { const int row = row0 + ai * 128 + m * 16; const float r = rs_of(ss, row);
                f32x4 h[2];
#pragma unroll
                for (int n = 0; n < 2; ++n) { const f32x4 g = acc[ai][0][m][n] * r, up = acc[ai][1][m][n] * r;
#pragma unroll
                    for (int e = 0; e < 4; ++e) h[n][e] = siluf_(g[e]) * up[e]; }
                *(u32x4*)(H + (size_t)row * FF + col0) = pack8(h[0], h[1]); }
    }
};
struct EpiResid {
    static constexpr bool PERM = true;
    const float* xin; float* xout; bf16* xb; float* ssout; float alpha;
    __device__ __forceinline__ void operator()(acc_t& acc, const Unit& u, int wr, int wc, int fr, int fq, int, int) const {
        const int row0 = u.pm * 256 + wr * 64 + fr, col0 = u.pn * 256 + wc * 32 + 8 * fq;
#pragma unroll
        for (int ai = 0; ai < 2; ++ai)
#pragma unroll
            for (int m = 0; m < 4; ++m) { const int row = row0 + ai * 128 + m * 16; float part = 0.f;
#pragma unroll
                for (int bj = 0; bj < 2; ++bj) { const size_t off = (size_t)row * D + col0 + bj * 128;
                    const f32x4 a0 = *(const f32x4*)(xin + off), a1 = *(const f32x4*)(xin + off + 4);
                    const f32x4 o0 = a0 + acc[ai][bj][m][0] * alpha, o1 = a1 + acc[ai][bj][m][1] * alpha;
                    *(f32x4*)(xout + off) = o0; *(f32x4*)(xout + off + 4) = o1;
                    *(u32x4*)(xb + off) = pack8(o0, o1);
                    part += (o0[0] * o0[0] + o0[1] * o0[1]) + (o0[2] * o0[2] + o0[3] * o0[3]) + (o1[0] * o1[0] + o1[1] * o1[1]) + (o1[2] * o1[2] + o1[3] * o1[3]); }
                part += __shfl_xor(part, 16); part += __shfl_xor(part, 32);
                if (ssout && fq == 0) atomicAdd(ssout + row, part); }
    }
};
struct EpiPlain {
    static constexpr bool PERM = true;
    bf16* O; int ldc; const float* ss; float cs;
    __device__ __forceinline__ void operator()(acc_t& acc, const Unit& u, int wr, int wc, int fr, int fq, int, int) const {
        const int row0 = u.pm * 256 + wr * 64 + fr, col0 = u.pn * 256 + wc * 32 + 8 * fq;
#pragma unroll
        for (int ai = 0; ai < 2; ++ai)
#pragma unroll
            for (int m = 0; m < 4; ++m) { const int row = row0 + ai * 128 + m * 16; const float r = (ss ? rs_of(ss, row) : 1.0f) * cs;
#pragma unroll
                for (int bj = 0; bj < 2; ++bj) *(u32x4*)(O + (size_t)row * ldc + col0 + bj * 128) = pack8(acc[ai][bj][m][0] * r, acc[ai][bj][m][1] * r); }
    }
};
struct EpiWin {
    static constexpr bool PERM = true;
    const float* ss; const float* lbraw; bf16* hq; float* logf; bf16* hi; bf16* hsg; bf16* sbq; bf16* sbk; bf16* sbv;
    __device__ __forceinline__ void operator()(acc_t& acc, const Unit& u, int wr, int wc, int fr, int fq, int, int) const {
        const int row0 = u.pm * 256 + wr * 64 + fr; const int seg = u.pn >> 1; const int cseg0 = (u.pn & 1) * 256 + wc * 32 + 8 * fq;
        if (seg == 1) {
            float lb[2][8];
#pragma unroll
            for (int bj = 0; bj < 2; ++bj)
#pragma unroll
                for (int e = 0; e < 8; ++e) { const int c = cseg0 + bj * 128 + e; lb[bj][e] = rcpf_(1.0f + ex2((lbraw[HGW + c] - lbraw[c]) * LOG2E)); }
#pragma unroll
            for (int ai = 0; ai < 2; ++ai)
#pragma unroll
                for (int m = 0; m < 4; ++m) { const int row = row0 + ai * 128 + m * 16; const float r = rs_of(ss, row);
#pragma unroll
                    for (int bj = 0; bj < 2; ++bj) { f32x4 o[2];
#pragma unroll
                        for (int n = 0; n < 2; ++n)
#pragma unroll
                            for (int e = 0; e < 4; ++e) { const float v = acc[ai][bj][m][n][e] * r; const float l = lb[bj][4 * n + e]; const float f = l + (1.0f - l) * sigmoidf_(v); o[n][e] = lg2(f) * LN2; }
                        float* p = logf + (size_t)row * HGW + cseg0 + bj * 128; *(f32x4*)p = o[0]; *(f32x4*)(p + 4) = o[1]; } }
            return;
        }
#pragma unroll
        for (int ai = 0; ai < 2; ++ai)
#pragma unroll
            for (int m = 0; m < 4; ++m) { const int row = row0 + ai * 128 + m * 16; const float r = rs_of(ss, row);
#pragma unroll
                for (int bj = 0; bj < 2; ++bj) { f32x4 v0 = acc[ai][bj][m][0] * r, v1 = acc[ai][bj][m][1] * r; const int cs = cseg0 + bj * 128;
                    bf16* dst;
                    if (seg == 0) dst = hq + (size_t)row * HGW + cs;
                    else if (seg == 2) dst = hi + (size_t)row * HGW + cs;
                    else if (seg == 3) { dst = hsg + (size_t)row * HGW + cs;
#pragma unroll
                        for (int e = 0; e < 4; ++e) { v0[e] = siluf_(v0[e]); v1[e] = siluf_(v1[e]); } }
                    else { const int b = row >> 13, s = row & (SEQ - 1), head = cs >> 6, d = cs & 63; const size_t o = ((size_t)(b * SBH + head) * SEQ + s) * SBD + d;
                        if (seg == 4) { dst = sbq + o; v0 = v0 * SB_QSCALE; v1 = v1 * SB_QSCALE; } else if (seg == 5) dst = sbk + o; else dst = sbv + o; }
                    *(u32x4*)dst = pack8(v0, v1); } }
    }
};
struct EpiSoftmax {
    static constexpr bool PERM = true;
    bf16* P; PG8_LAS unsigned char* xl;
    __device__ __forceinline__ void operator()(acc_t& acc, const Unit& u, int wr, int wc, int fr, int fq, int, int) const {
        typedef float f32x2v __attribute__((ext_vector_type(2)));
        PG8_LAS f32x2v* X = (PG8_LAS f32x2v*)xl;
        float mw[2][4];
#pragma unroll
        for (int ai = 0; ai < 2; ++ai)
#pragma unroll
            for (int m = 0; m < 4; ++m) { float mx = -3.0e38f;
#pragma unroll
                for (int bj = 0; bj < 2; ++bj)
#pragma unroll
                    for (int n = 0; n < 2; ++n) { const f32x4 v = acc[ai][bj][m][n]; mx = fmaxf(fmaxf(fmaxf(mx, v[0]), fmaxf(v[1], v[2])), v[3]); }
                mx = fmaxf(mx, __shfl_xor(mx, 16)); mx = fmaxf(mx, __shfl_xor(mx, 32));
                float s = 0.f;
#pragma unroll
                for (int bj = 0; bj < 2; ++bj)
#pragma unroll
                    for (int n = 0; n < 2; ++n) { f32x4 v = acc[ai][bj][m][n];
#pragma unroll
                        for (int e = 0; e < 4; ++e) { v[e] = ex2(v[e] - mx); s += v[e]; }
                        acc[ai][bj][m][n] = v; }
                s += __shfl_xor(s, 16); s += __shfl_xor(s, 32);
                if (fq == 0) X[(ai * 128 + wr * 64 + m * 16 + fr) * 4 + wc] = (f32x2v){mx, s};
                mw[ai][m] = mx; }
        asm volatile("s_waitcnt lgkmcnt(0)" ::: "memory"); __builtin_amdgcn_s_barrier(); asm volatile("" ::: "memory");
        const int row0 = u.pm * 256 + wr * 64 + fr, col0 = u.pn * 256 + wc * 32 + 8 * fq;
#pragma unroll
        for (int ai = 0; ai < 2; ++ai)
#pragma unroll
            for (int m = 0; m < 4; ++m) { const int rl = ai * 128 + wr * 64 + m * 16 + fr;
                const f32x2v a = X[rl * 4 + 0], b = X[rl * 4 + 1], c = X[rl * 4 + 2], d = X[rl * 4 + 3];
                const float mt = fmaxf(fmaxf(a.x, b.x), fmaxf(c.x, d.x));
                const float tot = a.y * ex2(a.x - mt) + b.y * ex2(b.x - mt) + c.y * ex2(c.x - mt) + d.y * ex2(d.x - mt);
                const float f = ex2(mw[ai][m] - mt) * rcpf_(tot);
                const int row = row0 + ai * 128 + m * 16;
#pragma unroll
                for (int bj = 0; bj < 2; ++bj) *(u32x4*)(P + (size_t)row * D + col0 + bj * 128) = pack8(acc[ai][bj][m][0] * f, acc[ai][bj][m][1] * f); }
    }
};

struct CrossOrder {
    const char* A; const char* B; int G, c, mode;
    __device__ __forceinline__ bool next(int i, Unit& u) const {
        const int L = i * G + c; if (L >= 512) return false;
        u.pm = L >> 2; u.pn = L & 3; const int b = u.pm >> 5;
        u.a = A + ((size_t)u.pm * 256 * D + u.pn * 256) * 2;
        u.b = mode == 0 ? B + ((size_t)b * 256 * D + u.pn * 256) * 2 : B + ((size_t)u.pn * 256 * D + b * 256) * 2;
        return true;
    }
};
struct OneUnit {
    const char* a; const char* b; int pm, pn;
    __device__ __forceinline__ bool next(int i, Unit& u) const { if (i > 0) return false; u.pm = pm; u.pn = pn; u.a = a; u.b = b; return true; }
};

typedef pg8::bf16x8 bf16x8;
typedef float f32x16 __attribute__((ext_vector_type(16)));
typedef short s16x4 __attribute__((ext_vector_type(4)));
typedef float f32x2_t __attribute__((ext_vector_type(2)));
typedef __bf16 bf16x2_t __attribute__((ext_vector_type(2)));
typedef unsigned u32x2 __attribute__((ext_vector_type(2)));
__device__ __forceinline__ unsigned cvtpk(float lo, float hi) { f32x2_t v = {lo, hi}; bf16x2_t b = __builtin_convertvector(v, bf16x2_t); return __builtin_bit_cast(unsigned, b); }
__device__ __forceinline__ s16x4 ldtr(LAS const unsigned char* p) { return __builtin_bit_cast(s16x4, __builtin_amdgcn_ds_read_tr16_b64_v4i16((LAS s16x4*)p)); }
__device__ __forceinline__ int crow(int r, int hi) { return (r & 3) + 8 * (r >> 2) + 4 * hi; }
#define MFMA32(a, b, c) __builtin_amdgcn_mfma_f32_32x32x16_bf16((a), (b), (c), 0, 0, 0)
__device__ __forceinline__ bf16x8 trfrag(LAS const unsigned char* tile, int pitch, int xbase, int k0, int k1, int lane) {
    const int colb = (xbase + 16 * ((lane >> 4) & 1) + 4 * (lane & 3)) * 2, rq = (lane & 15) >> 2;
    const s16x4 lo = ldtr(tile + (k0 + rq) * pitch + colb), hi = ldtr(tile + (k1 + rq) * pitch + colb);
    return (bf16x8){lo[0], lo[1], lo[2], lo[3], hi[0], hi[1], hi[2], hi[3]};
}
template <int S8> __device__ __forceinline__ bf16x8 acc_frag(const f32x16& v) {
    pg8::u32x4 w; w.x = cvtpk(v[8 * S8 + 0], v[8 * S8 + 1]); w.y = cvtpk(v[8 * S8 + 2], v[8 * S8 + 3]); w.z = cvtpk(v[8 * S8 + 4], v[8 * S8 + 5]); w.w = cvtpk(v[8 * S8 + 6], v[8 * S8 + 7]);
    return __builtin_bit_cast(bf16x8, w);
}
template <int S8> __device__ __forceinline__ void acc_frag_hl(const f32x16& v, bf16x8& H, bf16x8& L) {
    pg8::u32x4 hw, lw;
#pragma unroll
    for (int p = 0; p < 4; ++p) { const float a = v[8 * S8 + 2 * p], b = v[8 * S8 + 2 * p + 1]; const unsigned hp = cvtpk(a, b); hw[p] = hp; lw[p] = cvtpk(a - bf_lo(hp), b - bf_hi(hp)); }
    H = __builtin_bit_cast(bf16x8, hw); L = __builtin_bit_cast(bf16x8, lw);
}
__device__ __forceinline__ float softplus2(float z) { return fmaxf(z, 0.f) + lg2(1.0f + ex2(-fabsf(z))); }

__device__ __forceinline__ void sb_qblock(const bf16* SBQ, const bf16* SBK, const bf16* SBV, const float* gsb, bf16* MIXED, int bh, int qi, LAS unsigned char* vl, int lane) {
    const int r32 = lane & 31, hi = lane >> 5, q0 = qi * 32, b = bh >> 3, h = bh & 7;
    const bf16* Qb = SBQ + ((size_t)bh * SEQ + q0) * SBD;
    bf16x8 qf[4];
#pragma unroll
    for (int ks = 0; ks < 4; ++ks) qf[ks] = *(const bf16x8*)(Qb + r32 * SBD + ks * 16 + hi * 8);
    bf16x8 tri[2];
#pragma unroll
    for (int s8 = 0; s8 < 2; ++s8)
#pragma unroll
        for (int j = 0; j < 8; ++j) { const int jk = 16 * s8 + 8 * (j >> 2) + 4 * hi + (j & 3); tri[s8][j] = jk >= r32 ? (short)0x3F80 : (short)0; }
    const bf16x8 ones = {(short)0x3F80, (short)0x3F80, (short)0x3F80, (short)0x3F80, (short)0x3F80, (short)0x3F80, (short)0x3F80, (short)0x3F80};
    f32x16 ot0 = {}, ot1 = {}; float carry = 0.f;
    const int kt_top = q0 >> 6, qrel = (q0 & 63) + r32;
    for (int kt = kt_top; kt >= 0; --kt) {
        const bf16* Kt = SBK + ((size_t)bh * SEQ + kt * 64) * SBD; const bf16* Vt = SBV + ((size_t)bh * SEQ + kt * 64) * SBD;
        v4u vv[8];
#pragma unroll
        for (int i = 0; i < 8; ++i) vv[i] = *(const v4u*)(Vt + (i * 64 + lane) * 8);
        bf16x8 kf[2][4];
#pragma unroll
        for (int kb = 0; kb < 2; ++kb)
#pragma unroll
            for (int ks = 0; ks < 4; ++ks) kf[kb][ks] = *(const bf16x8*)(Kt + (32 * kb + r32) * SBD + ks * 16 + hi * 8);
        asm volatile("" ::: "memory");
#pragma unroll
        for (int i = 0; i < 8; ++i) *(LAS v4u*)(vl + (i * 64 + lane) * 16) = vv[i];
        asm volatile("" ::: "memory");
        f32x16 st0 = {}, st1 = {};
#pragma unroll
        for (int ks = 0; ks < 4; ++ks) { st0 = MFMA32(kf[0][ks], qf[ks], st0); st1 = MFMA32(kf[1][ks], qf[ks], st1); }
        const int qlim = kt == kt_top ? qrel - 4 * hi : 4096;
        f32x16 sp0, sp1;
#pragma unroll
        for (int r = 0; r < 16; ++r) { const int key = (r & 3) + 8 * (r >> 2); const bool v0 = key < qlim, v1 = key + 32 < qlim;
            sp0[r] = v0 ? softplus2(st0[r]) : 0.f; sp1[r] = v1 ? softplus2(st1[r]) : 0.f; }
        bf16x8 H00, H01, H10, H11, L00, L01, L10, L11;
        acc_frag_hl<0>(sp0, H00, L00); acc_frag_hl<1>(sp0, H01, L01); acc_frag_hl<0>(sp1, H10, L10); acc_frag_hl<1>(sp1, H11, L11);
        f32x16 c0, c1;
#pragma unroll
        for (int r = 0; r < 16; ++r) { c0[r] = carry; c1[r] = carry; }
        c0 = MFMA32(tri[0], H00, c0); c0 = MFMA32(tri[1], H01, c0); c0 = MFMA32(tri[0], L00, c0); c0 = MFMA32(tri[1], L01, c0);
        c0 = MFMA32(ones, H10, c0); c0 = MFMA32(ones, H11, c0); c0 = MFMA32(ones, L10, c0); c0 = MFMA32(ones, L11, c0);
        c1 = MFMA32(tri[0], H10, c1); c1 = MFMA32(tri[1], H11, c1); c1 = MFMA32(tri[0], L10, c1); c1 = MFMA32(tri[1], L11, c1);
        f32x16 w0, w1;
#pragma unroll
        for (int r = 0; r < 16; ++r) { const int key = (r & 3) + 8 * (r >> 2); const bool v0 = key < qlim, v1 = key + 32 < qlim;
            w0[r] = v0 ? ex2(st0[r] - c0[r]) : 0.f; w1[r] = v1 ? ex2(st1[r] - c1[r]) : 0.f; }
        carry = __shfl(c0[0], r32);
        const bf16x8 p00 = acc_frag<0>(w0), p01 = acc_frag<1>(w0), p10 = acc_frag<0>(w1), p11 = acc_frag<1>(w1);
        asm volatile("" ::: "memory");
        ot0 = MFMA32(trfrag(vl, 128, 0, 0 + 4 * hi, 8 + 4 * hi, lane), p00, ot0);   ot1 = MFMA32(trfrag(vl, 128, 32, 0 + 4 * hi, 8 + 4 * hi, lane), p00, ot1);
        ot0 = MFMA32(trfrag(vl, 128, 0, 16 + 4 * hi, 24 + 4 * hi, lane), p01, ot0); ot1 = MFMA32(trfrag(vl, 128, 32, 16 + 4 * hi, 24 + 4 * hi, lane), p01, ot1);
        ot0 = MFMA32(trfrag(vl, 128, 0, 32 + 4 * hi, 40 + 4 * hi, lane), p10, ot0); ot1 = MFMA32(trfrag(vl, 128, 32, 32 + 4 * hi, 40 + 4 * hi, lane), p10, ot1);
        ot0 = MFMA32(trfrag(vl, 128, 0, 48 + 4 * hi, 56 + 4 * hi, lane), p11, ot0); ot1 = MFMA32(trfrag(vl, 128, 32, 48 + 4 * hi, 56 + 4 * hi, lane), p11, ot1);
        asm volatile("" ::: "memory");
        if (__all(carry > SB_STOP)) break;
    }
    float ssq = 0.f;
#pragma unroll
    for (int r = 0; r < 16; ++r) ssq += ot0[r] * ot0[r] + ot1[r] * ot1[r];
    ssq += __shfl_xor(ssq, 32);
    const float rstd = __builtin_amdgcn_rsqf(ssq * (1.0f / (float)SBD) + EPS);
    bf16* orow = MIXED + ((size_t)b * SEQ + q0 + r32) * D + HGW + h * SBD;
#pragma unroll
    for (int rg = 0; rg < 4; ++rg) { const int d0 = 8 * rg + 4 * hi;
        const f32x4 g0 = *(const f32x4*)(gsb + h * SBD + d0), g1 = *(const f32x4*)(gsb + h * SBD + 32 + d0);
        u32x2 a, c2; a.x = cvtpk(ot0[4 * rg] * rstd * g0[0], ot0[4 * rg + 1] * rstd * g0[1]); a.y = cvtpk(ot0[4 * rg + 2] * rstd * g0[2], ot0[4 * rg + 3] * rstd * g0[3]);
        c2.x = cvtpk(ot1[4 * rg] * rstd * g1[0], ot1[4 * rg + 1] * rstd * g1[1]); c2.y = cvtpk(ot1[4 * rg + 2] * rstd * g1[2], ot1[4 * rg + 3] * rstd * g1[3]);
        *(u32x2*)(orow + d0) = a; *(u32x2*)(orow + 32 + d0) = c2; }
}

constexpr int HG_T0 = 0, HG_T1 = 16384, HG_T2 = 32768, HG_T3 = 49152, HG_TOT = 65536, HG_SSQ = HG_TOT + 2048;
__device__ __forceinline__ void hg_front(const float* LOGF, const bf16* HI, size_t rbase, int h, LAS unsigned char* lds, int tid, float (&lf)[16], float (&bb)[16], float& all, float& mid) {
    const int ch = tid & 127, tg = tid >> 7;
#pragma unroll
    for (int i = 0; i < 2; ++i) { const int chunk = tid + 512 * i, row = chunk >> 4, cc = chunk & 15;
        *(LAS v4u*)(lds + HG_T3 + row * 256 + cc * 16) = *(const v4u*)(HI + (rbase + row) * HGW + h * HGD + cc * 8); }
    float run = 0.f;
#pragma unroll
    for (int k = 0; k < 16; ++k) { lf[k] = LOGF[(rbase + tg * 16 + k) * HGW + h * HGD + ch]; }
#pragma unroll
    for (int k = 0; k < 16; ++k) { run += lf[k]; bb[k] = run; }
    LAS float* TOT = (LAS float*)(lds + HG_TOT);
    TOT[tg * 128 + ch] = run;
    __syncthreads();
    const float t0 = TOT[ch], t1 = TOT[128 + ch], t2 = TOT[256 + ch], t3 = TOT[384 + ch];
    const float pre = tg == 0 ? 0.f : tg == 1 ? t0 : tg == 2 ? t0 + t1 : t0 + t1 + t2;
    all = (t0 + t1) + (t2 + t3); mid = t0 + t1;
#pragma unroll
    for (int k = 0; k < 16; ++k) bb[k] += pre;
}
__device__ __forceinline__ void hg_pass1(const float* LOGF, const bf16* HI, bf16* ST, float* DVEC, int item, LAS unsigned char* lds, int tid, int wave, int lane) {
    const int c = item & 127, bh = item >> 7, b = bh >> 2, h = bh & 3; const size_t rbase = (size_t)b * SEQ + c * 64;
    const int ch = tid & 127, tg = tid >> 7, r32 = lane & 31, hi = lane >> 5;
    float lf[16], bb[16], all, mid;
    hg_front(LOGF, HI, rbase, h, lds, tid, lf, bb, all, mid);
#pragma unroll
    for (int k = 0; k < 16; ++k) { const float f = ex2(lf[k] * LOG2E); const float kd = (1.0f - f) * ex2((all - bb[k]) * LOG2E);
        *(LAS bf16*)(lds + HG_T0 + (tg * 16 + k) * 256 + ch * 2) = (bf16)f2bf(kd); }
    if (tg == 0) DVEC[(size_t)item * HGD + ch] = ex2(all * LOG2E);
    __syncthreads();
    const int dkb = wave >> 1;
#pragma unroll
    for (int tl = 0; tl < 2; ++tl) { const int dvb = 2 * (wave & 1) + tl; f32x16 acc = {};
#pragma unroll
        for (int ks = 0; ks < 4; ++ks) { const int k0 = 16 * ks + 8 * hi;
            acc = MFMA32(trfrag(lds + HG_T0, 256, 32 * dkb, k0, k0 + 4, lane), trfrag(lds + HG_T3, 256, 32 * dvb, k0, k0 + 4, lane), acc); }
        bf16* dst = ST + ((size_t)item * HGD + 32 * dvb + r32) * HGD + 32 * dkb;
#pragma unroll
        for (int rg = 0; rg < 4; ++rg) { u32x2 w; w.x = cvtpk(acc[4 * rg], acc[4 * rg + 1]); w.y = cvtpk(acc[4 * rg + 2], acc[4 * rg + 3]); *(u32x2*)(dst + 8 * rg + 4 * hi) = w; } }
    __syncthreads();
}
__device__ __forceinline__ void hg_pass3(const float* LOGF, const bf16* HQ, const bf16* HI, const bf16* HSG, const bf16* ST, const float* ghg, bf16* MIXED, int item, LAS unsigned char* lds, int tid, int wave, int lane) {
    const int c = item & 127, bh = item >> 7, b = bh >> 2, h = bh & 3; const size_t rbase = (size_t)b * SEQ + c * 64;
    const int ch = tid & 127, tg = tid >> 7, r32 = lane & 31, hi = lane >> 5;
    float lf[16], bb[16], all, mid;
    hg_front(LOGF, HI, rbase, h, lds, tid, lf, bb, all, mid);
#pragma unroll
    for (int k = 0; k < 16; ++k) { const int t = tg * 16 + k; const float q = bf2f(HQ[(rbase + t) * HGW + h * HGD + ch]);
        const float f = ex2(lf[k] * LOG2E); const float e1 = fminf(fmaxf(bb[k] - mid, -80.f), 80.f) * LOG2E;
        *(LAS bf16*)(lds + HG_T0 + t * 256 + ch * 2) = (bf16)f2bf(q * ex2(bb[k] * LOG2E));
        *(LAS bf16*)(lds + HG_T1 + t * 256 + ch * 2) = (bf16)f2bf(q * ex2(e1));
        *(LAS bf16*)(lds + HG_T2 + t * 256 + ch * 2) = (bf16)f2bf((1.0f - f) * ex2(-e1)); }
    __syncthreads();
    const int dvb = wave >> 1, tb = wave & 1;
    f32x16 ot = {};
#pragma unroll
    for (int ks = 0; ks < 8; ++ks)
        ot = MFMA32(*(const bf16x8*)(ST + ((size_t)item * HGD + 32 * dvb + r32) * HGD + 16 * ks + 8 * hi), *(const LAS bf16x8*)(lds + HG_T0 + (32 * tb + r32) * 256 + (16 * ks + 8 * hi) * 2), ot);
#pragma unroll
    for (int sb = 0; sb < 2; ++sb) {
        if (sb <= tb) {
            f32x16 at = {};
#pragma unroll
            for (int ks = 0; ks < 8; ++ks)
                at = MFMA32(*(const LAS bf16x8*)(lds + HG_T2 + (32 * sb + r32) * 256 + (16 * ks + 8 * hi) * 2), *(const LAS bf16x8*)(lds + HG_T1 + (32 * tb + r32) * 256 + (16 * ks + 8 * hi) * 2), at);
            if (sb == tb) {
#pragma unroll
                for (int r = 0; r < 16; ++r) at[r] = ((r & 3) + 8 * (r >> 2)) <= r32 - 4 * hi ? at[r] : 0.f;
            }
            const bf16x8 p0 = acc_frag<0>(at), p1 = acc_frag<1>(at);
            ot = MFMA32(trfrag(lds + HG_T3, 256, 32 * dvb, 32 * sb + 4 * hi, 32 * sb + 8 + 4 * hi, lane), p0, ot);
            ot = MFMA32(trfrag(lds + HG_T3, 256, 32 * dvb, 32 * sb + 16 + 4 * hi, 32 * sb + 24 + 4 * hi, lane), p1, ot);
        }
    }
    float ssq = 0.f;
#pragma unroll
    for (int r = 0; r < 16; ++r) ssq += ot[r] * ot[r];
    ssq += __shfl_xor(ssq, 32);
    LAS float* SSQ = (LAS float*)(lds + HG_SSQ);
    if (hi == 0) SSQ[dvb * 64 + 32 * tb + r32] = ssq;
    __syncthreads();
    const int tl = 32 * tb + r32;
    const float rstd = __builtin_amdgcn_rsqf(((SSQ[tl] + SSQ[64 + tl]) + (SSQ[128 + tl] + SSQ[192 + tl])) * (1.0f / (float)HGD) + EPS);
    const size_t row = rbase + tl;
#pragma unroll
    for (int rg = 0; rg < 4; ++rg) { const int col = h * HGD + 32 * dvb + 8 * rg + 4 * hi;
        const f32x4 g = *(const f32x4*)(ghg + col); const u32x2 sg = *(const u32x2*)(HSG + row * HGW + col);
        u32x2 w; w.x = cvtpk(ot[4 * rg] * rstd * g[0] * bf_lo(sg.x), ot[4 * rg + 1] * rstd * g[1] * bf_hi(sg.x)); w.y = cvtpk(ot[4 * rg + 2] * rstd * g[2] * bf_lo(sg.y), ot[4 * rg + 3] * rstd * g[3] * bf_hi(sg.y));
        *(u32x2*)(MIXED + row * D + col) = w; }
    __syncthreads();
}

struct Args { const float* in[20]; float* out; unsigned char* ws; int ph_lo, ph_hi; };

__device__ __forceinline__ void transpose_item(const float* W, int K, int N, bf16* WT, const float* gain, int mode, LAS float* scr, int item, int lane) {
    const int nblk = N / 32, kb = item / nblk, nb = item % nblk, k0 = 64 * kb, n0 = 32 * nb;
#pragma unroll 8
    for (int i = 0; i < 32; ++i) { const int kk = 2 * i + (lane >> 5); const float g = gain ? gain[k0 + kk] : 1.0f; scr[kk * 33 + (lane & 31)] = W[(size_t)(k0 + kk) * N + n0 + (lane & 31)] * g; }
    LDS_WAIT(); asm volatile("" ::: "memory");
    int orow0 = n0;
    if (mode == 1) { const int j = n0 < FF ? n0 : n0 - FF; orow0 = (j >> 7) * 256 + (n0 < FF ? 0 : 128) + (j & 127); }
    const int c = lane & 7;
#pragma unroll
    for (int j = 0; j < 4; ++j) { const int n = (lane >> 3) + 8 * j; const LAS float* s = scr + (8 * c) * 33 + n;
        v4u o; o.x = pk2(s[0 * 33], s[1 * 33]); o.y = pk2(s[2 * 33], s[3 * 33]); o.z = pk2(s[4 * 33], s[5 * 33]); o.w = pk2(s[6 * 33], s[7 * 33]);
        *(GAS v4u*)(WT + (size_t)(orow0 + n) * K + k0 + 8 * c) = o; }
    LDS_WAIT(); asm volatile("" ::: "memory");
}

__global__ void __launch_bounds__(NWAVES * 64, 2) layer_fwd(Args args) {
    extern __shared__ __attribute__((aligned(16))) unsigned char lds_raw[];
    LAS unsigned char* lds = (LAS unsigned char*)lds_raw;
    volatile LAS unsigned* MISC = (volatile LAS unsigned*)(lds + MISC_OFF);
    const int tid = threadIdx.x, lane = tid & 63, wave = __builtin_amdgcn_readfirstlane(tid >> 6);
    const int G = gridDim.x, bx = blockIdx.x;
    const int vcu = (G % 8 == 0) ? (bx % 8) * (G / 8) + bx / 8 : bx;
    unsigned char* ws = args.ws;
    gu32* ctl = (gu32*)(ws + WS_CTL);
    float* ss0 = (float*)(ws + WS_SS); float* ss1 = ss0 + M; float* ss2 = ss1 + M; float* ss3 = ss2 + M;
    bf16* Wgu1 = (bf16*)(ws + WS_WGU1); bf16* Wd1 = (bf16*)(ws + WS_WD1); bf16* Win = (bf16*)(ws + WS_WIN); bf16* Wout = (bf16*)(ws + WS_WOUT);
    bf16* Wq = (bf16*)(ws + WS_WQ); bf16* Wkv = (bf16*)(ws + WS_WKV); bf16* Wo = (bf16*)(ws + WS_WO); bf16* Wgu2 = (bf16*)(ws + WS_WGU2); bf16* Wd2 = (bf16*)(ws + WS_WD2);
    bf16* MN = (bf16*)(ws + WS_MN); bf16* KMEM = (bf16*)(ws + WS_KMEM); bf16* VT = (bf16*)(ws + WS_VT);
    bf16* XB = (bf16*)(ws + WS_XB); bf16* HMID = (bf16*)(ws + WS_HMID);
    bf16* HQ = (bf16*)(ws + WS_HQ); float* LOGF = (float*)(ws + WS_LOGF); bf16* HI = (bf16*)(ws + WS_HI); bf16* HSG = (bf16*)(ws + WS_HSG);
    bf16* SBQ = (bf16*)(ws + WS_SBQ); bf16* SBK = (bf16*)(ws + WS_SBK); bf16* SBV = (bf16*)(ws + WS_SBV);
    bf16* MIXED = (bf16*)(ws + WS_MIXED); bf16* STb = (bf16*)(ws + WS_ST); float* DVEC = (float*)(ws + WS_DVEC); bf16* QC = (bf16*)(ws + WS_QC); bf16* PMb = (bf16*)(ws + WS_PM); bf16* OC = (bf16*)(ws + WS_OC);
    const float* x_in = args.in[0]; float* out = args.out;

    for (int u = tid; u < (LDS_BYTES - LDSCTL_OFF) / 4; u += NWAVES * 64) ((LAS unsigned*)(lds + LDSCTL_OFF))[u] = 0u;
    __syncthreads();
#if MK_ONE_LAUNCH
    XcdBarrier bar = xcd_barrier_post((unsigned*)(ctl + CW_BAR), MISC + 8);
#define GRID_BAR() xcd_barrier(bar)
#else
#define GRID_BAR() do { } while (0)
#endif
    const int lo = args.ph_lo, hi = args.ph_hi;
#define IN(k) (lo <= (k) && (k) < hi)
#define SEAM(k) do { if (IN(k) && IN((k) + 1)) GRID_BAR(); } while (0)
    const int gw = vcu * NWAVES + wave, NGW = G * NWAVES;

    if (IN(0)) {
        LAS float* scr = (LAS float*)(lds + wave * 16384);
        constexpr int I_GU = (D / 64) * (GU / 32), I_DN = (FF / 64) * (D / 32), I_IN = (D / 64) * (INC / 32), I_SQ = (D / 64) * (D / 32), I_KV = (D / 64) * (2 * D / 32);
        constexpr int NITEMS = 2 * I_GU + 2 * I_DN + I_IN + 3 * I_SQ + I_KV;
        for (int it = gw; it < NITEMS; it += NGW) {
            int r = it;
            if (r < I_GU) { transpose_item(args.in[3], D, GU, Wgu1, args.in[2], 1, scr, r, lane); continue; } r -= I_GU;
            if (r < I_GU) { transpose_item(args.in[17], D, GU, Wgu2, args.in[16], 1, scr, r, lane); continue; } r -= I_GU;
            if (r < I_DN) { transpose_item(args.in[4], FF, D, Wd1, nullptr, 0, scr, r, lane); continue; } r -= I_DN;
            if (r < I_DN) { transpose_item(args.in[18], FF, D, Wd2, nullptr, 0, scr, r, lane); continue; } r -= I_DN;
            if (r < I_IN) { transpose_item(args.in[6], D, INC, Win, args.in[5], 0, scr, r, lane); continue; } r -= I_IN;
            if (r < I_SQ) { transpose_item(args.in[10], D, D, Wout, nullptr, 0, scr, r, lane); continue; } r -= I_SQ;
            if (r < I_SQ) { transpose_item(args.in[13], D, D, Wq, args.in[11], 0, scr, r, lane); continue; } r -= I_SQ;
            if (r < I_SQ) { transpose_item(args.in[15], D, D, Wo, nullptr, 0, scr, r, lane); continue; } r -= I_SQ;
            transpose_item(args.in[14], D, 2 * D, Wkv, nullptr, 0, scr, r, lane);
        }
        for (int m = gw; m < M; m += NGW) {
            const GAS f32x4* xr = (const GAS f32x4*)(x_in + (size_t)m * D) + lane; f32x4 v[4]; float s = 0.f;
#pragma unroll
            for (int j = 0; j < 4; ++j) { v[j] = xr[64 * j]; s += (v[j].x * v[j].x + v[j].y * v[j].y) + (v[j].z * v[j].z + v[j].w * v[j].w); }
            s = wave_sum(s);
            GAS unsigned long long* o8 = (GAS unsigned long long*)(XB + (size_t)m * D) + lane;
#pragma unroll
            for (int j = 0; j < 4; ++j) o8[64 * j] = (unsigned long long)pk2(v[j].x, v[j].y) | ((unsigned long long)pk2(v[j].z, v[j].w) << 32);
            if (lane == 0) ss0[m] = s;
        }
        for (int m = gw; m < MROWS; m += NGW) {
            const GAS f32x4* xr = (const GAS f32x4*)(args.in[1] + (size_t)m * D) + lane; const GAS f32x4* gr = (const GAS f32x4*)(args.in[12]) + lane; f32x4 v[4]; float s = 0.f;
#pragma unroll
            for (int j = 0; j < 4; ++j) { v[j] = xr[64 * j]; s += (v[j].x * v[j].x + v[j].y * v[j].y) + (v[j].z * v[j].z + v[j].w * v[j].w); }
            const float r = __builtin_amdgcn_rsqf(wave_sum(s) * (1.0f / (float)D) + EPS);
            GAS unsigned long long* o8 = (GAS unsigned long long*)(MN + (size_t)m * D) + lane;
#pragma unroll
            for (int j = 0; j < 4; ++j) { const f32x4 g = gr[64 * j]; o8[64 * j] = (unsigned long long)pk2(v[j].x * r * g.x, v[j].y * r * g.y) | ((unsigned long long)pk2(v[j].z * r * g.z, v[j].w * r * g.w) << 32); }
        }
    }
    SEAM(0);
    if (IN(1)) { pg8::TileOrder S; S.init(XB, Wgu1, D, D, M, GU, G, bx); EpiSwiglu E{HMID, ss0}; pg8::gemm_phase(lds, D, D, D, S, E); }
    SEAM(1);
    if (IN(2)) { pg8::TileOrder S; S.init(HMID, Wd1, FF, FF, M, D, G, bx); EpiResid E{x_in, out, XB, ss1, 0.5f}; pg8::gemm_phase(lds, FF, FF, FF, S, E); }
    SEAM(2);
    if (IN(3)) { pg8::TileOrder S; S.init(XB, Win, D, D, M, INC, G, bx); EpiWin E{ss1, args.in[7], HQ, LOGF, HI, HSG, SBQ, SBK, SBV}; pg8::gemm_phase(lds, D, D, D, S, E); }
    SEAM(3);
    if (IN(4)) {
        for (int it = bx; it < BATCH * HGH * (SEQ / 64); it += G) hg_pass1(LOGF, HI, STb, DVEC, it, lds, tid, wave, lane);
        for (int T = bx; T < BATCH * SBH * (SEQ / 256); T += G)
            sb_qblock(SBQ, SBK, SBV, args.in[9], MIXED, T >> 5, (T & 31) * 8 + wave, lds + wave * 8192, lane);
    }
    SEAM(4);
    if (IN(5)) {
        if (bx < 16) {
            const int L = bx; OneUnit S{(const char*)(MN + (size_t)(L >> 2) * 256 * D), (const char*)(Wkv + (size_t)(L & 3) * 256 * D), L >> 2, L & 3};
            EpiPlain E{KMEM, D, nullptr, 1.0f}; pg8::gemm_phase(lds, D, D, D, S, E);
        } else if (bx < 32) {
            const int L = bx - 16; OneUnit S{(const char*)(Wkv + (size_t)(D + (L >> 2) * 256) * D), (const char*)(MN + (size_t)(L & 3) * 256 * D), L >> 2, L & 3};
            EpiPlain E{VT, D, nullptr, 1.0f}; pg8::gemm_phase(lds, D, D, D, S, E);
        } else {
            const int gid = (bx - 32) * 512 + tid;
            if (gid < BATCH * HGH * HGD * HGD / 4) {
                const int bh = gid >> 12, e = (gid & 4095) * 4, dk = e & 127;
                bf16* sp = STb + (size_t)bh * 128 * (HGD * HGD) + e; const float* dp = DVEC + (size_t)bh * 128 * HGD + dk;
                f32x4 Sv = {0.f, 0.f, 0.f, 0.f};
                for (int c0 = 0; c0 < 128; c0 += 8) {
                    u32x2 u[8]; f32x4 dd[8];
#pragma unroll
                    for (int j = 0; j < 8; ++j) { u[j] = *(const u32x2*)(sp + (size_t)(c0 + j) * (HGD * HGD)); dd[j] = *(const f32x4*)(dp + (size_t)(c0 + j) * HGD); }
#pragma unroll
                    for (int j = 0; j < 8; ++j) { u32x2 o; o.x = cvtpk(Sv[0], Sv[1]); o.y = cvtpk(Sv[2], Sv[3]); *(u32x2*)(sp + (size_t)(c0 + j) * (HGD * HGD)) = o;
                        Sv[0] = dd[j][0] * Sv[0] + bf_lo(u[j].x); Sv[1] = dd[j][1] * Sv[1] + bf_hi(u[j].x); Sv[2] = dd[j][2] * Sv[2] + bf_lo(u[j].y); Sv[3] = dd[j][3] * Sv[3] + bf_hi(u[j].y); }
                }
            }
        }
    }
    SEAM(5);
    if (IN(6)) { for (int it = bx; it < BATCH * HGH * (SEQ / 64); it += G) hg_pass3(LOGF, HQ, HI, HSG, STb, args.in[8], MIXED, it, lds, tid, wave, lane); }
    SEAM(6);
    if (IN(7)) { pg8::TileOrder S; S.init(MIXED, Wout, D, D, M, D, G, bx); EpiResid E{out, out, XB, ss2, 1.0f}; pg8::gemm_phase(lds, D, D, D, S, E); }
    SEAM(7);
    if (IN(8)) { pg8::TileOrder S; S.init(XB, Wq, D, D, M, D, G, bx); EpiPlain E{QC, D, ss2, CA_QSCALE}; pg8::gemm_phase(lds, D, D, D, S, E); }
    SEAM(8);
    if (IN(9)) { CrossOrder S{(const char*)QC, (const char*)KMEM, G, bx, 0}; EpiSoftmax E{PMb, lds + EPI_OFF}; int kc = CHD; asm volatile("" : "+s"(kc)); pg8::gemm_phase(lds, kc, D, D, S, E); }
    SEAM(9);
    if (IN(10)) { CrossOrder S{(const char*)PMb, (const char*)VT, G, bx, 1}; EpiPlain E{OC, D, nullptr, 1.0f}; int kc = NMEM; asm volatile("" : "+s"(kc)); pg8::gemm_phase(lds, kc, D, D, S, E); }
    SEAM(10);
    if (IN(11)) { pg8::TileOrder S; S.init(OC, Wo, D, D, M, D, G, bx); EpiResid E{out, out, XB, ss3, 1.0f}; pg8::gemm_phase(lds, D, D, D, S, E); }
    SEAM(11);
    if (IN(12)) { pg8::TileOrder S; S.init(XB, Wgu2, D, D, M, GU, G, bx); EpiSwiglu E{HMID, ss3}; pg8::gemm_phase(lds, D, D, D, S, E); }
    SEAM(12);
    if (IN(13)) { pg8::TileOrder S; S.init(HMID, Wd2, FF, FF, M, D, G, bx); EpiResid E{out, out, XB, nullptr, 0.5f}; pg8::gemm_phase(lds, FF, FF, FF, S, E); }
    SEAM(13);
    if (IN(14)) {
        const GAS f32x4* gr = (const GAS f32x4*)(args.in[19]) + lane;
        for (int m = gw; m < M; m += NGW) {
            GAS f32x4* xr = (GAS f32x4*)(out + (size_t)m * D) + lane; f32x4 v[4]; float s = 0.f;
#pragma unroll
            for (int j = 0; j < 4; ++j) { v[j] = xr[64 * j]; s += (v[j].x * v[j].x + v[j].y * v[j].y) + (v[j].z * v[j].z + v[j].w * v[j].w); }
            const float r = __builtin_amdgcn_rsqf(wave_sum(s) * (1.0f / (float)D) + EPS);
#pragma unroll
            for (int j = 0; j < 4; ++j) { const f32x4 g = gr[64 * j]; xr[64 * j] = v[j] * r * g; }
        }
    }
#undef IN
#undef SEAM
}

constexpr int N_PHASES = 15;
extern "C" void kernel_launch(void* const* d_in, const int* in_sizes, int n_in, void* d_out, int out_size, void* d_ws, size_t ws_size, hipStream_t stream) {
    static int grid = 0;
    if (grid == 0) {
        if (n_in != 20 || in_sizes[0] != M * D || out_size != M * D || ws_size < WS_END) { fprintf(stderr, "kernel_launch: unexpected shapes (n_in %d, in0 %d, out %d, ws %zu)\n", n_in, n_in > 0 ? in_sizes[0] : -1, out_size, ws_size); grid = -1; return; }
        int dev = 0, cus = 0;
        if (hipGetDevice(&dev) != hipSuccess || hipDeviceGetAttribute(&cus, hipDeviceAttributeMultiprocessorCount, dev) != hipSuccess) { grid = -1; return; }
        if (hipFuncSetAttribute((const void*)layer_fwd, hipFuncAttributeMaxDynamicSharedMemorySize, LDS_BYTES) != hipSuccess) { fprintf(stderr, "kernel_launch: hipFuncSetAttribute failed\n"); grid = -1; return; }
        int per_cu = 0;
        if (hipOccupancyMaxActiveBlocksPerMultiprocessor(&per_cu, (const void*)layer_fwd, NWAVES * 64, LDS_BYTES) != hipSuccess || per_cu < 1) fprintf(stderr, "kernel_launch: occupancy query says %d\n", per_cu);
        (void)hipGetLastError();
        grid = cus;
    }
    if (grid < 0) return;
    if (hipMemsetAsync((char*)d_ws + WS_CTL, 0, CTL_ZERO_BYTES, stream) != hipSuccess) return;
    Args a{};
    for (int i = 0; i < 20; ++i) a.in[i] = (const float*)d_in[i];
    a.out = (float*)d_out; a.ws = (unsigned char*)d_ws;
#if MK_ONE_LAUNCH
    a.ph_lo = 0; a.ph_hi = N_PHASES;
    hipLaunchKernelGGL(layer_fwd, dim3(grid), dim3(NWAVES * 64), LDS_BYTES, stream, a);
#else
    for (int p = 0; p < N_PHASES; ++p) { a.ph_lo = p; a.ph_hi = p + 1; hipLaunchKernelGGL(layer_fwd, dim3(grid), dim3(NWAVES * 64), LDS_BYTES, stream, a); }
#endif
}
```

```cpp
#include <hip/hip_runtime.h>
#include <cstdio>
#include <cstdint>

#ifndef MK_ONE_LAUNCH
#define MK_ONE_LAUNCH 1
#endif

namespace pg8 {
#define PG8_LAS __attribute__((address_space(3)))
typedef unsigned short bf16_t;
typedef short bf16x8 __attribute__((ext_vector_type(8)));
typedef float f32x4 __attribute__((ext_vector_type(4)));
typedef float f32x2 __attribute__((ext_vector_type(2)));
typedef unsigned u32x4 __attribute__((ext_vector_type(4)));
constexpr int BM = 256, BK = 64, HALF = 128, HTB = HALF * BK * 2, STAGE_BYTES = 8 * HTB, NXCD = 8, WGM = 8;

__host__ __device__ __forceinline__ int lds_byte(int r, int c) { const int st = (r >> 4) * 2 + (c >> 5), rr = r & 15, cc = c & 31, ob = rr * 64 + cc * 2; return st * 1024 + (ob ^ (((ob >> 9) & 1) << 5)); }
__host__ __device__ __forceinline__ void stage_rc(int b, int& R, int& C) { const int st = b / 1024, sb = b % 1024, swz = sb ^ (((sb >> 9) & 1) << 5); R = (st >> 1) * 16 + swz / 64; C = (st & 1) * 32 + (swz % 64) / 2; }
__host__ __device__ __forceinline__ int perm32(int rho) { const int n = rho >> 4, i = rho & 15; return 8 * (i >> 2) + 4 * n + (i & 3); }

struct Unit { int pm, pn; const char* a; const char* b; };

__device__ __forceinline__ unsigned cvt_pk_bf16(float lo, float hi) { unsigned r; asm volatile("v_cvt_pk_bf16_f32 %0, %1, %2" : "=v"(r) : "v"(lo), "v"(hi)); return r; }

struct TileOrder {
    const char* A; const char* B; int lda, ldb; int nM, nN, nwg, G, c;
    __device__ __forceinline__ void init(const void* A_, const void* B_, int lda_, int ldb_, int M, int N, int G_, int c_) { A = (const char*)A_; B = (const char*)B_; lda = lda_; ldb = ldb_; nM = M / BM; nN = N / BM; nwg = nM * nN; G = G_; c = c_; }
    __device__ __forceinline__ bool next(int i, Unit& u) const {
        const long L = (long)i * G + c; if (L >= nwg) return false;
        int wgid = (int)L; { const int q = nwg / NXCD, r = nwg % NXCD, xcd = wgid % NXCD, off = wgid / NXCD; wgid = (xcd < r ? xcd * (q + 1) : r * (q + 1) + (xcd - r) * q) + off; }
        const int nig = WGM * nN, gid = wgid / nig, fm = gid * WGM, gsz = (nM - fm) < WGM ? (nM - fm) : WGM;
        u.pm = fm + ((wgid % nig) % gsz); u.pn = (wgid % nig) / gsz;
        u.a = A + (size_t)u.pm * BM * lda * 2; u.b = B + (size_t)u.pn * BM * ldb * 2; return true;
    }
};

template <class Epi, class Sched>
__device__ __forceinline__ void gemm_phase(PG8_LAS unsigned char* lds, const int K, const int lda, const int ldb, const Sched& S, const Epi& E) {
    const int tid = threadIdx.x, wid = __builtin_amdgcn_readfirstlane(tid >> 6), lane = tid & 63, wr = wid >> 2, wc = wid & 3, fr = lane & 15, fq = lane >> 4;
    const int nt = K / BK;
    unsigned voffA[2], voffB[2];
#pragma unroll
    for (int i = 0; i < 2; ++i) { int R, C; stage_rc(tid * 16 + i * 8192, R, C); const int Rb = Epi::PERM ? ((R & ~31) + perm32(R & 31)) : R;
        voffA[i] = (unsigned)(R * lda + C) * 2u; voffB[i] = (unsigned)(Rb * ldb + C) * 2u; }
    const size_t kstep = (size_t)(BK * 2);
    const size_t hstepA = (size_t)HALF * lda * 2, hstepB = (size_t)HALF * ldb * 2;
    const unsigned ldsw = (unsigned)wid * 1024u;
    const int aoff = lds_byte(wr * 64 + fr, fq * 8), boff = lds_byte(wc * 32 + fr, fq * 8);
#define PG8_SA(b, h) (((b) * 2 + (h)) * HTB)
#define PG8_SB(b, h) ((4 + (b) * 2 + (h)) * HTB)
#define PG8_STAGE(bufoff, gbase, voff) do { _Pragma("unroll") for (int _i = 0; _i < 2; ++_i) \
        __builtin_amdgcn_global_load_lds((const unsigned*)((const char*)(gbase) + (voff)[_i]), (PG8_LAS unsigned*)(lds + (bufoff) + ldsw + _i * 8192), 16, 0, 0); } while (0)
#define PG8_LDA(dst, b, h) do { _Pragma("unroll") for (int m = 0; m < 4; ++m) _Pragma("unroll") for (int k = 0; k < 2; ++k) dst[m][k] = *(const PG8_LAS bf16x8*)(lds + PG8_SA(b, h) + aoff + m * 2048 + k * 1024); } while (0)
#define PG8_LDB(dst, b, h) do { _Pragma("unroll") for (int n = 0; n < 2; ++n) _Pragma("unroll") for (int k = 0; k < 2; ++k) dst[n][k] = *(const PG8_LAS bf16x8*)(lds + PG8_SB(b, h) + boff + n * 2048 + k * 1024); } while (0)
#define PG8_MMA(ai, bj, At, Bt) do { __builtin_amdgcn_s_setprio(1); _Pragma("unroll") for (int m = 0; m < 4; ++m) _Pragma("unroll") for (int n = 0; n < 2; ++n) _Pragma("unroll") for (int k = 0; k < 2; ++k) \
        acc[ai][bj][m][n] = __builtin_amdgcn_mfma_f32_16x16x32_bf16(Bt[n][k], At[m][k], acc[ai][bj][m][n], 0, 0, 0); __builtin_amdgcn_s_setprio(0); } while (0)
#define PG8_WAIT_V(n) asm volatile("s_waitcnt vmcnt(" #n ")" ::: "memory")
#define PG8_WAIT_L(n) asm volatile("s_waitcnt lgkmcnt(" #n ")" ::: "memory")
#define PG8_BAR __builtin_amdgcn_s_barrier()
#define PG8_SCHED __builtin_amdgcn_sched_barrier(0)
    Unit cur, nxt; int ui = 0;
    if (!S.next(0, cur)) return;
    f32x4 acc[2][2][4][2];
#pragma unroll
    for (int a = 0; a < 2; ++a)
#pragma unroll
        for (int b = 0; b < 2; ++b)
#pragma unroll
            for (int m = 0; m < 4; ++m)
#pragma unroll
                for (int n = 0; n < 2; ++n) acc[a][b][m][n] = (f32x4){0.f, 0.f, 0.f, 0.f};
    bf16x8 At[4][2], B0[2][2], B1[2][2];
    const char* cA = cur.a; const char* cB = cur.b;
    PG8_STAGE(PG8_SB(0, 0), cB, voffB); PG8_STAGE(PG8_SB(0, 1), cB + hstepB, voffB); PG8_STAGE(PG8_SA(0, 0), cA, voffA); PG8_STAGE(PG8_SA(0, 1), cA + hstepA, voffA);
    if (wr == 1) PG8_BAR;
    PG8_WAIT_V(2); PG8_BAR;
    PG8_STAGE(PG8_SB(1, 0), cB + kstep, voffB); PG8_STAGE(PG8_SA(1, 0), cA + kstep, voffA); PG8_STAGE(PG8_SB(1, 1), cB + hstepB + kstep, voffB);
    PG8_WAIT_V(6); PG8_BAR;
    for (;;) {
        const bool has_next = S.next(ui + 1, nxt);
        const char* nA = has_next ? nxt.a : cA; const char* nB = has_next ? nxt.b : cB;
        for (int t = 0; t < nt; t += 2) {
            const bool last = (t == nt - 2);
            const char* a1 = cA + (size_t)(t + 1) * kstep;
            const char* a2 = last ? nA : cA + (size_t)(t + 2) * kstep; const char* b2 = last ? nB : cB + (size_t)(t + 2) * kstep;
            const char* a3 = a2 + kstep; const char* b3 = b2 + kstep;
            PG8_LDB(B0, 0, 0); PG8_LDB(B1, 0, 1); PG8_SCHED; PG8_LDA(At, 0, 0); PG8_STAGE(PG8_SA(1, 1), a1 + hstepA, voffA);
            PG8_WAIT_V(8); PG8_WAIT_L(0); PG8_BAR; PG8_MMA(0, 0, At, B0); PG8_MMA(0, 1, At, B1); PG8_BAR; PG8_SCHED;
            PG8_LDA(At, 0, 1); PG8_STAGE(PG8_SB(0, 0), b2, voffB); PG8_STAGE(PG8_SB(0, 1), b2 + hstepB, voffB); PG8_STAGE(PG8_SA(0, 0), a2, voffA);
            PG8_WAIT_V(8); PG8_WAIT_L(0); PG8_BAR; PG8_MMA(1, 0, At, B0); PG8_MMA(1, 1, At, B1); PG8_BAR; PG8_SCHED;
            PG8_LDB(B0, 1, 0); PG8_LDB(B1, 1, 1); PG8_SCHED; PG8_LDA(At, 1, 0); PG8_STAGE(PG8_SA(0, 1), a2 + hstepA, voffA);
            PG8_WAIT_V(8); PG8_WAIT_L(0); PG8_BAR; PG8_MMA(0, 0, At, B0); PG8_MMA(0, 1, At, B1); PG8_BAR; PG8_SCHED;
            PG8_LDA(At, 1, 1); PG8_STAGE(PG8_SB(1, 0), b3, voffB); PG8_STAGE(PG8_SB(1, 1), b3 + hstepB, voffB); PG8_STAGE(PG8_SA(1, 0), a3, voffA);
            PG8_WAIT_V(8); PG8_WAIT_L(0); PG8_BAR; PG8_MMA(1, 0, At, B0); PG8_MMA(1, 1, At, B1); PG8_BAR; PG8_SCHED;
        }
        if (wr == 0) PG8_BAR;
        E(acc, cur, wr, wc, fr, fq, wid, lane);
        if (!has_next) break;
#pragma unroll
        for (int a = 0; a < 2; ++a)
#pragma unroll
            for (int b = 0; b < 2; ++b)
#pragma unroll
                for (int m = 0; m < 4; ++m)
#pragma unroll
                    for (int n = 0; n < 2; ++n) acc[a][b][m][n] = (f32x4){0.f, 0.f, 0.f, 0.f};
        cur = nxt; cA = nA; cB = nB; ++ui;
        if (wr == 1) PG8_BAR;
    }
    PG8_WAIT_V(0);
    PG8_BAR;
#undef PG8_SA
#undef PG8_SB
#undef PG8_STAGE
#undef PG8_LDA
#undef PG8_LDB
#undef PG8_MMA
#undef PG8_WAIT_V
#undef PG8_WAIT_L
#undef PG8_BAR
#undef PG8_SCHED
}
}

constexpr int NWAVES = 8;
constexpr int BATCH = 4, SEQ = 8192, D = 1024, M = BATCH * SEQ;
constexpr int FF = 2816, GU = 2 * FF, INC = 3584, NMEM = 256, MROWS = BATCH * NMEM;
constexpr int HGW = 512, HGH = 4, HGD = 128, SBW = 512, SBH = 8, SBD = 64, CHD = 256;
constexpr float EPS = 1e-6f, LOG2E = 1.4426950408889634f, LN2 = 0.6931471805599453f;
constexpr float SB_QSCALE = 0.125f * LOG2E;
constexpr float CA_QSCALE = 0.0625f * LOG2E;
constexpr float SB_STOP = 160.0f;

constexpr size_t MiB = 1u << 20;
constexpr size_t WS_CTL = 0, CTL_ZERO_BYTES = 2 * MiB;
constexpr size_t WS_SS = 1 * MiB;
constexpr size_t WS_WGU1 = 2 * MiB, WS_WD1 = 13 * MiB, WS_WIN = 19 * MiB, WS_WOUT = 26 * MiB, WS_WQ = 28 * MiB, WS_WKV = 30 * MiB, WS_WO = 34 * MiB, WS_WGU2 = 36 * MiB, WS_WD2 = 47 * MiB;
constexpr size_t WS_MN = 53 * MiB, WS_KMEM = 55 * MiB, WS_VT = 57 * MiB, WS_DVEC = 59 * MiB;
constexpr size_t WS_XB = 64 * MiB;
constexpr size_t WS_HMID = 128 * MiB;
constexpr size_t WS_HQ = 128 * MiB, WS_LOGF = 160 * MiB, WS_HI = 224 * MiB, WS_HSG = 256 * MiB;
constexpr size_t WS_SBQ = 304 * MiB, WS_SBK = 336 * MiB, WS_SBV = 368 * MiB;
constexpr size_t WS_MIXED = 400 * MiB;
constexpr size_t WS_QC = 128 * MiB, WS_PM = 192 * MiB, WS_OC = 304 * MiB;
constexpr size_t WS_END = 464 * MiB;
constexpr int CW_TMO = 0, CW_CODE = 1, CW_BAR = 4096;

constexpr int RING_BYTES = 131072;
constexpr int LDSCTL_OFF = RING_BYTES, MISC_OFF = LDSCTL_OFF + 320;
constexpr int EPI_OFF = RING_BYTES + 1024;
constexpr int LDS_BYTES = 147456;

#define GAS __attribute__((address_space(1)))
#define LAS __attribute__((address_space(3)))
typedef unsigned short bf16;
typedef unsigned v4u __attribute__((ext_vector_type(4)));
typedef float f32x4 __attribute__((ext_vector_type(4)));
typedef GAS unsigned gu32;
#define RLX_AGENT __ATOMIC_RELAXED, __HIP_MEMORY_SCOPE_AGENT
#define LDS_WAIT() asm volatile("s_waitcnt lgkmcnt(0)" ::: "memory")
#define VM_WAIT() asm volatile("s_waitcnt vmcnt(0)" ::: "memory")
__device__ __forceinline__ unsigned f2bf(float f) { unsigned u = __builtin_bit_cast(unsigned, f); return (u + 0x7fffu + ((u >> 16) & 1u)) >> 16; }
__device__ __forceinline__ unsigned pk2(float lo, float hi) { return f2bf(lo) | (f2bf(hi) << 16); }
__device__ __forceinline__ float bf_lo(unsigned w) { return __builtin_bit_cast(float, w << 16); }
__device__ __forceinline__ float bf_hi(unsigned w) { return __builtin_bit_cast(float, w & 0xffff0000u); }
__device__ __forceinline__ float bf2f(bf16 h) { return __builtin_bit_cast(float, (unsigned)h << 16); }
__device__ __forceinline__ float ex2(float x) { return __builtin_amdgcn_exp2f(x); }
__device__ __forceinline__ float lg2(float x) { return __builtin_amdgcn_logf(x); }
__device__ __forceinline__ float rcpf_(float x) { return __builtin_amdgcn_rcpf(x); }
__device__ __forceinline__ float sigmoidf_(float v) { return rcpf_(1.0f + ex2(-v * LOG2E)); }
__device__ __forceinline__ float siluf_(float v) { return v * sigmoidf_(v); }
__device__ __forceinline__ float rdlane(float v, int l) { return __builtin_bit_cast(float, __builtin_amdgcn_readlane(__builtin_bit_cast(int, v), l)); }
__device__ __forceinline__ float wave_sum(float v) {
#pragma unroll
    for (int o = 1; o < 64; o <<= 1) v += __shfl_xor(v, o);
    return v;
}

#define XB_TMO      128
#define XB_XCNT(j)  (256  + 64 * (j))
#define XB_XSUB(j)  (1280 + 64 * (j))
#define XB_XGEN(j)  (2304 + 64 * (j))
#define XB_TOP      3328
#define XB_TOPGEN   3392
#define XCD_BAR_WORDS 3456
#define XB_SPIN_CAP (1u << 18)
__device__ __forceinline__ unsigned xb_ld(unsigned* p)              { return __hip_atomic_load(p, __ATOMIC_RELAXED, __HIP_MEMORY_SCOPE_AGENT); }
__device__ __forceinline__ unsigned xb_add(unsigned* p, unsigned v) { return __hip_atomic_fetch_add(p, v, __ATOMIC_RELAXED, __HIP_MEMORY_SCOPE_AGENT); }
__device__ __forceinline__ unsigned xb_xcc_id() { return (unsigned)__builtin_amdgcn_s_getreg((3 << 11) | 20) & 0xFu; }
#define XB_SPIN(cond, bar) do { unsigned _sp = 0; while (cond) { __builtin_amdgcn_s_sleep(1); \
    if ((++_sp & 255u) == 0u) { if (xb_ld(&(bar)[XB_TMO])) break; if (_sp > XB_SPIN_CAP) { atomicAdd(&(bar)[XB_TMO], 1u); break; } } } } while (0)
struct XcdBarrier { unsigned* bar; unsigned x; volatile LAS unsigned* st; };
__device__ __forceinline__ XcdBarrier xcd_barrier_post(unsigned* bar, volatile LAS unsigned* st) {
    XcdBarrier b; b.bar = bar; b.x = xb_xcc_id(); b.st = st;
    if (threadIdx.x == 0) (void)xb_add(&bar[XB_XCNT(b.x)], 1u);
    return b;
}
__device__ __forceinline__ void xcd_barrier_complete(unsigned* bar, unsigned x, unsigned& nloc, unsigned& nx) {
    const unsigned G = gridDim.x * gridDim.y * gridDim.z;
    unsigned sum, cnt, mine, sp = 0u;
    for (;;) {
        sum = 0u; cnt = 0u; mine = 0u;
#pragma unroll
        for (unsigned j = 0; j < 16; ++j) { const unsigned c = xb_ld(&bar[XB_XCNT(j)]); sum += c; cnt += (c > 0u) ? 1u : 0u; mine = (j == x) ? c : mine; }
        if (sum == G) break;
        __builtin_amdgcn_s_sleep(1);
        if ((++sp & 255u) == 0u) { if (xb_ld(&bar[XB_TMO])) break; if (sp > XB_SPIN_CAP) { atomicAdd(&bar[XB_TMO], 1u); break; } }
    }
    nloc = mine > 0u ? mine : 1u; nx = cnt > 0u ? cnt : 1u;
}
__device__ __forceinline__ void xcd_barrier(const XcdBarrier& b) {
    asm volatile("s_waitcnt vmcnt(0)" ::: "memory");
    __syncthreads();
    if (threadIdx.x == 0) {
        unsigned* bar = b.bar;
        __builtin_amdgcn_s_waitcnt(0);
        unsigned nloc = b.st[0], nx = b.st[1];
        if (nloc == 0u) { xcd_barrier_complete(bar, b.x, nloc, nx); b.st[0] = nloc; b.st[1] = nx; }
        const unsigned old = xb_add(&bar[XB_XSUB(b.x)], 1u);
        const unsigned gen = old / nloc;
        if (old + 1u == (gen + 1u) * nloc) {
            __builtin_amdgcn_fence(__ATOMIC_RELEASE, "agent");
            asm volatile("s_waitcnt vmcnt(0)" ::: "memory");
            const unsigned og = xb_add(&bar[XB_TOP], 1u);
            const unsigned tg = og / nx;
            if (og + 1u == (tg + 1u) * nx) xb_add(&bar[XB_TOPGEN], 1u);
            else XB_SPIN(xb_ld(&bar[XB_TOPGEN]) == tg, bar);
            __builtin_amdgcn_fence(__ATOMIC_ACQUIRE, "agent");
            xb_add(&bar[XB_XGEN(b.x)], 1u);
            asm volatile("s_waitcnt vmcnt(0)" ::: "memory");
        } else {
            XB_SPIN(xb_ld(&bar[XB_XGEN(b.x)]) == gen, bar);
            __builtin_amdgcn_fence(__ATOMIC_ACQUIRE, "agent");
            asm volatile("s_waitcnt vmcnt(0)" ::: "memory");
        }
    }
    __syncthreads();
}

using pg8::f32x4; using pg8::u32x4; using pg8::Unit; using pg8::cvt_pk_bf16;
typedef f32x4 acc_t[2][2][4][2];
__device__ __forceinline__ float rs_of(const float* ss, int row) { return __builtin_amdgcn_rsqf(ss[row] * (1.0f / (float)D) + EPS); }
__device__ __forceinline__ u32x4 pack8(const f32x4 a, const f32x4 b) { u32x4 w; w.x = cvt_pk_bf16(a[0], a[1]); w.y = cvt_pk_bf16(a[2], a[3]); w.z = cvt_pk_bf16(b[0], b[1]); w.w = cvt_pk_bf16(b[2], b[3]); return w; }

struct EpiSwiglu {
    static constexpr bool PERM = true;
    bf16* H; const float* ss;
    __device__ __forceinline__ void operator()(acc_t& acc, const Unit& u, int wr, int wc, int fr, int fq, int, int) const {
        const int row0 = u.pm * 256 + wr * 64 + fr, col0 = u.pn * 128 + wc * 32 + 8 * fq;
#pragma unroll
        for (int ai = 0; ai < 2; ++ai)
#pragma unroll
            for (int m = 0; m < 4; ++m) { const int row = row0 + ai * 128 + m * 16; const float r = rs_of(ss, row);
                f32x4 h[2];
#pragma unroll
                for (int n = 0; n < 2; ++n) { const f32x4 g = acc[ai][0][m][n] * r, up = acc[ai][1][m][n] * r;
#pragma unroll
                    for (int e = 0; e < 4; ++e) h[n][e] = siluf_(g[e]) * up[e]; }
                *(u32x4*)(H + (size_t)row * FF + col0) = pack8(h[0], h[1]); }
    }
};
template <bool IN_F32> struct EpiResid {
    static constexpr bool PERM = true;
    const void* xin; float* xf; bf16* xb; float* ssout; float alpha;
    __device__ __forceinline__ void operator()(acc_t& acc, const Unit& u, int wr, int wc, int fr, int fq, int, int) const {
        const int row0 = u.pm * 256 + wr * 64 + fr, col0 = u.pn * 256 + wc * 32 + 8 * fq;
#pragma unroll
        for (int ai = 0; ai < 2; ++ai)
#pragma unroll
            for (int m = 0; m < 4; ++m) { const int row = row0 + ai * 128 + m * 16; float part = 0.f;
#pragma unroll
                for (int bj = 0; bj < 2; ++bj) { const size_t off = (size_t)row * D + col0 + bj * 128;
                    f32x4 a0, a1;
                    if (IN_F32) { a0 = *(const f32x4*)((const float*)xin + off); a1 = *(const f32x4*)((const float*)xin + off + 4); }
                    else { const u32x4 w = *(const u32x4*)((const bf16*)xin + off); a0 = (f32x4){bf_lo(w.x), bf_hi(w.x), bf_lo(w.y), bf_hi(w.y)}; a1 = (f32x4){bf_lo(w.z), bf_hi(w.z), bf_lo(w.w), bf_hi(w.w)}; }
                    const f32x4 o0 = a0 + acc[ai][bj][m][0] * alpha, o1 = a1 + acc[ai][bj][m][1] * alpha;
                    if (xf) { *(f32x4*)(xf + off) = o0; *(f32x4*)(xf + off + 4) = o1; }
                    if (xb) *(u32x4*)(xb + off) = pack8(o0, o1);
                    part += (o0[0] * o0[0] + o0[1] * o0[1]) + (o0[2] * o0[2] + o0[3] * o0[3]) + (o1[0] * o1[0] + o1[1] * o1[1]) + (o1[2] * o1[2] + o1[3] * o1[3]); }
                if (ssout) { part += __shfl_xor(part, 16); part += __shfl_xor(part, 32); if (fq == 0) atomicAdd(ssout + row, part); } }
    }
};
struct EpiPlain {
    static constexpr bool PERM = true;
    bf16* O; int ldc; const float* ss; float cs;
    __device__ __forceinline__ void operator()(acc_t& acc, const Unit& u, int wr, int wc, int fr, int fq, int, int) const {
        const int row0 = u.pm * 256 + wr * 64 + fr, col0 = u.pn * 256 + wc * 32 + 8 * fq;
#pragma unroll
        for (int ai = 0; ai < 2; ++ai)
#pragma unroll
            for (int m = 0; m < 4; ++m) { const int row = row0 + ai * 128 + m * 16; const float r = (ss ? rs_of(ss, row) : 1.0f) * cs;
#pragma unroll
                for (int bj = 0; bj < 2; ++bj) *(u32x4*)(O + (size_t)row * ldc + col0 + bj * 128) = pack8(acc[ai][bj][m][0] * r, acc[ai][bj][m][1] * r); }
    }
};
struct EpiWin {
    static constexpr bool PERM = true;
    const float* ss; const float* lbraw; bf16* hq; float* logf; bf16* hi; bf16* hsg; bf16* sbq; bf16* sbk; bf16* sbv;
    __device__ __forceinline__ void operator()(acc_t& acc, const Unit& u, int wr, int wc, int fr, int fq, int, int) const {
        const int row0 = u.pm * 256 + wr * 64 + fr; const int seg = u.pn >> 1; const int cseg0 = (u.pn & 1) * 256 + wc * 32 + 8 * fq;
        if (seg == 1) {
            float lb[2][8];
#pragma unroll
            for (int bj = 0; bj < 2; ++bj)
#pragma unroll
                for (int e = 0; e < 8; ++e) { const int c = cseg0 + bj * 128 + e; lb[bj][e] = rcpf_(1.0f + ex2((lbraw[HGW + c] - lbraw[c]) * LOG2E)); }
#pragma unroll
            for (int ai = 0; ai < 2; ++ai)
#pragma unroll
                for (int m = 0; m < 4; ++m) { const int row = row0 + ai * 128 + m * 16; const float r = rs_of(ss, row);
#pragma unroll
                    for (int bj = 0; bj < 2; ++bj) { f32x4 o[2];
#pragma unroll
                        for (int n = 0; n < 2; ++n)
#pragma unroll
                            for (int e = 0; e < 4; ++e) { const float v = acc[ai][bj][m][n][e] * r; const float l = lb[bj][4 * n + e]; const float f = l + (1.0f - l) * sigmoidf_(v); o[n][e] = lg2(f) * LN2; }
                        float* p = logf + (size_t)row * HGW + cseg0 + bj * 128; *(f32x4*)p = o[0]; *(f32x4*)(p + 4) = o[1]; } }
            return;
        }
#pragma unroll
        for (int ai = 0; ai < 2; ++ai)
#pragma unroll
            for (int m = 0; m < 4; ++m) { const int row = row0 + ai * 128 + m * 16; const float r = rs_of(ss, row);
#pragma unroll
                for (int bj = 0; bj < 2; ++bj) { f32x4 v0 = acc[ai][bj][m][0] * r, v1 = acc[ai][bj][m][1] * r; const int cs = cseg0 + bj * 128;
                    bf16* dst;
                    if (seg == 0) dst = hq + (size_t)row * HGW + cs;
                    else if (seg == 2) dst = hi + (size_t)row * HGW + cs;
                    else if (seg == 3) { dst = hsg + (size_t)row * HGW + cs;
#pragma unroll
                        for (int e = 0; e < 4; ++e) { v0[e] = siluf_(v0[e]); v1[e] = siluf_(v1[e]); } }
                    else { const int b = row >> 13, s = row & (SEQ - 1), head = cs >> 6, d = cs & 63; const size_t o = ((size_t)(b * SBH + head) * SEQ + s) * SBD + d;
                        if (seg == 4) { dst = sbq + o; v0 = v0 * SB_QSCALE; v1 = v1 * SB_QSCALE; } else if (seg == 5) dst = sbk + o; else dst = sbv + o; }
                    *(u32x4*)dst = pack8(v0, v1); } }
    }
};
struct EpiSoftmax {
    static constexpr bool PERM = true;
    bf16* P; PG8_LAS unsigned char* xl;
    __device__ __forceinline__ void operator()(acc_t& acc, const Unit& u, int wr, int wc, int fr, int fq, int, int) const {
        typedef float f32x2v __attribute__((ext_vector_type(2)));
        PG8_LAS f32x2v* X = (PG8_LAS f32x2v*)xl;
        float mw[2][4];
#pragma unroll
        for (int ai = 0; ai < 2; ++ai)
#pragma unroll
            for (int m = 0; m < 4; ++m) { float mx = -3.0e38f;
#pragma unroll
                for (int bj = 0; bj < 2; ++bj)
#pragma unroll
                    for (int n = 0; n < 2; ++n) { const f32x4 v = acc[ai][bj][m][n]; mx = fmaxf(fmaxf(fmaxf(mx, v[0]), fmaxf(v[1], v[2])), v[3]); }
                mx = fmaxf(mx, __shfl_xor(mx, 16)); mx = fmaxf(mx, __shfl_xor(mx, 32));
                float s = 0.f;
#pragma unroll
                for (int bj = 0; bj < 2; ++bj)
#pragma unroll
                    for (int n = 0; n < 2; ++n) { f32x4 v = acc[ai][bj][m][n];
#pragma unroll
                        for (int e = 0; e < 4; ++e) { v[e] = ex2(v[e] - mx); s += v[e]; }
                        acc[ai][bj][m][n] = v; }
                s += __shfl_xor(s, 16); s += __shfl_xor(s, 32);
                if (fq == 0) X[(ai * 128 + wr * 64 + m * 16 + fr) * 4 + wc] = (f32x2v){mx, s};
                mw[ai][m] = mx; }
        asm volatile("s_waitcnt lgkmcnt(0)" ::: "memory"); __builtin_amdgcn_s_barrier(); asm volatile("" ::: "memory");
        const int row0 = u.pm * 256 + wr * 64 + fr, col0 = u.pn * 256 + wc * 32 + 8 * fq;
#pragma unroll
        for (int ai = 0; ai < 2; ++ai)
#pragma unroll
            for (int m = 0; m < 4; ++m) { const int rl = ai * 128 + wr * 64 + m * 16 + fr;
                const f32x2v a = X[rl * 4 + 0], b = X[rl * 4 + 1], c = X[rl * 4 + 2], d = X[rl * 4 + 3];
                const float mt = fmaxf(fmaxf(a.x, b.x), fmaxf(c.x, d.x));
                const float tot = a.y * ex2(a.x - mt) + b.y * ex2(b.x - mt) + c.y * ex2(c.x - mt) + d.y * ex2(d.x - mt);
                const float f = ex2(mw[ai][m] - mt) * rcpf_(tot);
                const int row = row0 + ai * 128 + m * 16;
#pragma unroll
                for (int bj = 0; bj < 2; ++bj) *(u32x4*)(P + (size_t)row * D + col0 + bj * 128) = pack8(acc[ai][bj][m][0] * f, acc[ai][bj][m][1] * f); }
    }
};

struct CrossOrder {
    const char* A; const char* B; int G, c, mode;
    __device__ __forceinline__ bool next(int i, Unit& u) const {
        const int L = i * G + c; if (L >= 512) return false;
        u.pm = L >> 2; u.pn = L & 3; const int b = u.pm >> 5;
        u.a = A + ((size_t)u.pm * 256 * D + u.pn * 256) * 2;
        u.b = mode == 0 ? B + ((size_t)b * 256 * D + u.pn * 256) * 2 : B + ((size_t)u.pn * 256 * D + b * 256) * 2;
        return true;
    }
};
struct OneUnit {
    const char* a; const char* b; int pm, pn;
    __device__ __forceinline__ bool next(int i, Unit& u) const { if (i > 0) return false; u.pm = pm; u.pn = pn; u.a = a; u.b = b; return true; }
};

typedef pg8::bf16x8 bf16x8;
typedef float f32x16 __attribute__((ext_vector_type(16)));
typedef short s16x4 __attribute__((ext_vector_type(4)));
typedef float f32x2_t __attribute__((ext_vector_type(2)));
typedef __bf16 bf16x2_t __attribute__((ext_vector_type(2)));
typedef unsigned u32x2 __attribute__((ext_vector_type(2)));
__device__ __forceinline__ unsigned cvtpk(float lo, float hi) { f32x2_t v = {lo, hi}; bf16x2_t b = __builtin_convertvector(v, bf16x2_t); return __builtin_bit_cast(unsigned, b); }
__device__ __forceinline__ s16x4 ldtr(LAS const unsigned char* p) { return __builtin_bit_cast(s16x4, __builtin_amdgcn_ds_read_tr16_b64_v4i16((LAS s16x4*)p)); }
__device__ __forceinline__ int crow(int r, int hi) { return (r & 3) + 8 * (r >> 2) + 4 * hi; }
#define MFMA32(a, b, c) __builtin_amdgcn_mfma_f32_32x32x16_bf16((a), (b), (c), 0, 0, 0)
__device__ __forceinline__ bf16x8 trfrag(LAS const unsigned char* tile, int pitch, int xbase, int k0, int k1, int lane) {
    const int colb = (xbase + 16 * ((lane >> 4) & 1) + 4 * (lane & 3)) * 2, rq = (lane & 15) >> 2;
    const s16x4 lo = ldtr(tile + (k0 + rq) * pitch + colb), hi = ldtr(tile + (k1 + rq) * pitch + colb);
    return (bf16x8){lo[0], lo[1], lo[2], lo[3], hi[0], hi[1], hi[2], hi[3]};
}
template <int S8> __device__ __forceinline__ bf16x8 acc_frag(const f32x16& v) {
    pg8::u32x4 w; w.x = cvtpk(v[8 * S8 + 0], v[8 * S8 + 1]); w.y = cvtpk(v[8 * S8 + 2], v[8 * S8 + 3]); w.z = cvtpk(v[8 * S8 + 4], v[8 * S8 + 5]); w.w = cvtpk(v[8 * S8 + 6], v[8 * S8 + 7]);
    return __builtin_bit_cast(bf16x8, w);
}
template <int S8> __device__ __forceinline__ void acc_frag_hl(const f32x16& v, bf16x8& H, bf16x8& L) {
    pg8::u32x4 hw, lw;
#pragma unroll
    for (int p = 0; p < 4; ++p) { const float a = v[8 * S8 + 2 * p], b = v[8 * S8 + 2 * p + 1]; const unsigned hp = cvtpk(a, b); hw[p] = hp; lw[p] = cvtpk(a - bf_lo(hp), b - bf_hi(hp)); }
    H = __builtin_bit_cast(bf16x8, hw); L = __builtin_bit_cast(bf16x8, lw);
}
__device__ __forceinline__ float softplus2(float z) { return fmaxf(z, 0.f) + lg2(1.0f + ex2(-fabsf(z))); }

__device__ __forceinline__ void sb_qblock(const bf16* SBQ, const bf16* SBK, const bf16* SBV, const float* gsb, bf16* MIXED, int bh, int qi, LAS unsigned char* vl, int lane) {
    const int r32 = lane & 31, hi = lane >> 5, q0 = qi * 32, b = bh >> 3, h = bh & 7;
    const bf16* Qb = SBQ + ((size_t)bh * SEQ + q0) * SBD;
    bf16x8 qf[4];
#pragma unroll
    for (int ks = 0; ks < 4; ++ks) qf[ks] = *(const bf16x8*)(Qb + r32 * SBD + ks * 16 + hi * 8);
    bf16x8 tri[2];
#pragma unroll
    for (int s8 = 0; s8 < 2; ++s8)
#pragma unroll
        for (int j = 0; j < 8; ++j) { const int jk = 16 * s8 + 8 * (j >> 2) + 4 * hi + (j & 3); tri[s8][j] = jk >= r32 ? (short)0x3F80 : (short)0; }
    const bf16x8 ones = {(short)0x3F80, (short)0x3F80, (short)0x3F80, (short)0x3F80, (short)0x3F80, (short)0x3F80, (short)0x3F80, (short)0x3F80};
    f32x16 ot0 = {}, ot1 = {}; float carry = 0.f;
    const int kt_top = q0 >> 6, qrel = (q0 & 63) + r32;
    for (int kt = kt_top; kt >= 0; --kt) {
        const bf16* Kt = SBK + ((size_t)bh * SEQ + kt * 64) * SBD; const bf16* Vt = SBV + ((size_t)bh * SEQ + kt * 64) * SBD;
        v4u vv[8];
#pragma unroll
        for (int i = 0; i < 8; ++i) vv[i] = *(const v4u*)(Vt + (i * 64 + lane) * 8);
        bf16x8 kf[2][4];
#pragma unroll
        for (int kb = 0; kb < 2; ++kb)
#pragma unroll
            for (int ks = 0; ks < 4; ++ks) kf[kb][ks] = *(const bf16x8*)(Kt + (32 * kb + r32) * SBD + ks * 16 + hi * 8);
        asm volatile("" ::: "memory");
#pragma unroll
        for (int i = 0; i < 8; ++i) *(LAS v4u*)(vl + (i * 64 + lane) * 16) = vv[i];
        asm volatile("" ::: "memory");
        f32x16 st0 = {}, st1 = {};
#pragma unroll
        for (int ks = 0; ks < 4; ++ks) { st0 = MFMA32(kf[0][ks], qf[ks], st0); st1 = MFMA32(kf[1][ks], qf[ks], st1); }
        const int qlim = kt == kt_top ? qrel - 4 * hi : 4096;
        f32x16 sp0, sp1;
#pragma unroll
        for (int r = 0; r < 16; ++r) { const int key = (r & 3) + 8 * (r >> 2); const bool v0 = key < qlim, v1 = key + 32 < qlim;
            sp0[r] = v0 ? softplus2(st0[r]) : 0.f; sp1[r] = v1 ? softplus2(st1[r]) : 0.f; }
        bf16x8 H00, H01, H10, H11, L00, L01, L10, L11;
        acc_frag_hl<0>(sp0, H00, L00); acc_frag_hl<1>(sp0, H01, L01); acc_frag_hl<0>(sp1, H10, L10); acc_frag_hl<1>(sp1, H11, L11);
        f32x16 c0, c1;
#pragma unroll
        for (int r = 0; r < 16; ++r) { c0[r] = carry; c1[r] = carry; }
        c0 = MFMA32(tri[0], H00, c0); c0 = MFMA32(tri[1], H01, c0); c0 = MFMA32(tri[0], L00, c0); c0 = MFMA32(tri[1], L01, c0);
        c0 = MFMA32(ones, H10, c0); c0 = MFMA32(ones, H11, c0); c0 = MFMA32(ones, L10, c0); c0 = MFMA32(ones, L11, c0);
        c1 = MFMA32(tri[0], H10, c1); c1 = MFMA32(tri[1], H11, c1); c1 = MFMA32(tri[0], L10, c1); c1 = MFMA32(tri[1], L11, c1);
        f32x16 w0, w1;
#pragma unroll
        for (int r = 0; r < 16; ++r) { const int key = (r & 3) + 8 * (r >> 2); const bool v0 = key < qlim, v1 = key + 32 < qlim;
            w0[r] = v0 ? ex2(st0[r] - c0[r]) : 0.f; w1[r] = v1 ? ex2(st1[r] - c1[r]) : 0.f; }
        carry = __shfl(c0[0], r32);
        const bf16x8 p00 = acc_frag<0>(w0), p01 = acc_frag<1>(w0), p10 = acc_frag<0>(w1), p11 = acc_frag<1>(w1);
        asm volatile("" ::: "memory");
        ot0 = MFMA32(trfrag(vl, 128, 0, 0 + 4 * hi, 8 + 4 * hi, lane), p00, ot0);   ot1 = MFMA32(trfrag(vl, 128, 32, 0 + 4 * hi, 8 + 4 * hi, lane), p00, ot1);
        ot0 = MFMA32(trfrag(vl, 128, 0, 16 + 4 * hi, 24 + 4 * hi, lane), p01, ot0); ot1 = MFMA32(trfrag(vl, 128, 32, 16 + 4 * hi, 24 + 4 * hi, lane), p01, ot1);
        ot0 = MFMA32(trfrag(vl, 128, 0, 32 + 4 * hi, 40 + 4 * hi, lane), p10, ot0); ot1 = MFMA32(trfrag(vl, 128, 32, 32 + 4 * hi, 40 + 4 * hi, lane), p10, ot1);
        ot0 = MFMA32(trfrag(vl, 128, 0, 48 + 4 * hi, 56 + 4 * hi, lane), p11, ot0); ot1 = MFMA32(trfrag(vl, 128, 32, 48 + 4 * hi, 56 + 4 * hi, lane), p11, ot1);
        asm volatile("" ::: "memory");
        if (__all(carry > SB_STOP)) break;
    }
    float ssq = 0.f;
#pragma unroll
    for (int r = 0; r < 16; ++r) ssq += ot0[r] * ot0[r] + ot1[r] * ot1[r];
    ssq += __shfl_xor(ssq, 32);
    const float rstd = __builtin_amdgcn_rsqf(ssq * (1.0f / (float)SBD) + EPS);
    bf16* orow = MIXED + ((size_t)b * SEQ + q0 + r32) * D + HGW + h * SBD;
#pragma unroll
    for (int rg = 0; rg < 4; ++rg) { const int d0 = 8 * rg + 4 * hi;
        const f32x4 g0 = *(const f32x4*)(gsb + h * SBD + d0), g1 = *(const f32x4*)(gsb + h * SBD + 32 + d0);
        u32x2 a, c2; a.x = cvtpk(ot0[4 * rg] * rstd * g0[0], ot0[4 * rg + 1] * rstd * g0[1]); a.y = cvtpk(ot0[4 * rg + 2] * rstd * g0[2], ot0[4 * rg + 3] * rstd * g0[3]);
        c2.x = cvtpk(ot1[4 * rg] * rstd * g1[0], ot1[4 * rg + 1] * rstd * g1[1]); c2.y = cvtpk(ot1[4 * rg + 2] * rstd * g1[2], ot1[4 * rg + 3] * rstd * g1[3]);
        *(u32x2*)(orow + d0) = a; *(u32x2*)(orow + 32 + d0) = c2; }
}

constexpr int HG_T0 = 0, HG_T1 = 16384, HG_T2 = 32768, HG_T3 = 49152, HG_TOT = 65536, HG_SSQ = HG_TOT + 2048;
__device__ __forceinline__ void hg_front(const float* LOGF, const bf16* HI, size_t rbase, int h, LAS unsigned char* lds, int tid, float (&lf)[16], float (&bb)[16], float& all, float& mid) {
    const int ch = tid & 127, tg = tid >> 7;
    v4u vt[2];
#pragma unroll
    for (int i = 0; i < 2; ++i) { const int chunk = tid + 512 * i, row = chunk >> 4, cc = chunk & 15; vt[i] = *(const v4u*)(HI + (rbase + row) * HGW + h * HGD + cc * 8); }
#pragma unroll
    for (int k = 0; k < 16; ++k) { lf[k] = LOGF[(rbase + tg * 16 + k) * HGW + h * HGD + ch]; }
    float run = 0.f;
#pragma unroll
    for (int k = 0; k < 16; ++k) { run += lf[k]; bb[k] = run; }
    LAS float* TOT = (LAS float*)(lds + HG_TOT);
    TOT[tg * 128 + ch] = run;
#pragma unroll
    for (int i = 0; i < 2; ++i) { const int chunk = tid + 512 * i, row = chunk >> 4, cc = chunk & 15; *(LAS v4u*)(lds + HG_T3 + row * 256 + cc * 16) = vt[i]; }
    __syncthreads();
    const float t0 = TOT[ch], t1 = TOT[128 + ch], t2 = TOT[256 + ch], t3 = TOT[384 + ch];
    const float pre = tg == 0 ? 0.f : tg == 1 ? t0 : tg == 2 ? t0 + t1 : t0 + t1 + t2;
    all = (t0 + t1) + (t2 + t3); mid = t0 + t1;
#pragma unroll
    for (int k = 0; k < 16; ++k) bb[k] += pre;
}
__device__ __forceinline__ void hg_pass1(const float* LOGF, const bf16* HI, bf16* ST, float* DVEC, int item, LAS unsigned char* lds, int tid, int wave, int lane) {
    const int c = item & 127, bh = item >> 7, b = bh >> 2, h = bh & 3; const size_t rbase = (size_t)b * SEQ + c * 64;
    const int ch = tid & 127, tg = tid >> 7, r32 = lane & 31, hi = lane >> 5;
    float lf[16], bb[16], all, mid;
    hg_front(LOGF, HI, rbase, h, lds, tid, lf, bb, all, mid);
#pragma unroll
    for (int k = 0; k < 16; ++k) { const float f = ex2(lf[k] * LOG2E); const float kd = (1.0f - f) * ex2((all - bb[k]) * LOG2E);
        *(LAS bf16*)(lds + HG_T0 + (tg * 16 + k) * 256 + ch * 2) = (bf16)f2bf(kd); }
    if (tg == 0) DVEC[(size_t)item * HGD + ch] = ex2(all * LOG2E);
    __syncthreads();
    const int dkb = wave >> 1;
#pragma unroll
    for (int tl = 0; tl < 2; ++tl) { const int dvb = 2 * (wave & 1) + tl; f32x16 acc = {};
#pragma unroll
        for (int ks = 0; ks < 4; ++ks) { const int k0 = 16 * ks + 8 * hi;
            acc = MFMA32(trfrag(lds + HG_T0, 256, 32 * dkb, k0, k0 + 4, lane), trfrag(lds + HG_T3, 256, 32 * dvb, k0, k0 + 4, lane), acc); }
        bf16* dst = ST + ((size_t)item * HGD + 32 * dvb + r32) * HGD + 32 * dkb;
#pragma unroll
        for (int rg = 0; rg < 4; ++rg) { u32x2 w; w.x = cvtpk(acc[4 * rg], acc[4 * rg + 1]); w.y = cvtpk(acc[4 * rg + 2], acc[4 * rg + 3]); *(u32x2*)(dst + 8 * rg + 4 * hi) = w; } }
    __syncthreads();
}
__device__ __forceinline__ void hg_pass3(const float* LOGF, const bf16* HQ, const bf16* HI, const bf16* HSG, const bf16* ST, const float* ghg, bf16* MIXED, int item, LAS unsigned char* lds, int tid, int wave, int lane) {
    const int c = item & 127, bh = item >> 7, b = bh >> 2, h = bh & 3; const size_t rbase = (size_t)b * SEQ + c * 64;
    const int ch = tid & 127, tg = tid >> 7, r32 = lane & 31, hi = lane >> 5;
    const int dvb = wave >> 1, tb = wave & 1, tl = 32 * tb + r32; const size_t row = rbase + tl;
    bf16x8 sf[8];
#pragma unroll
    for (int ks = 0; ks < 8; ++ks) sf[ks] = *(const bf16x8*)(ST + ((size_t)item * HGD + 32 * dvb + r32) * HGD + 16 * ks + 8 * hi);
    bf16 qraw[16];
#pragma unroll
    for (int k = 0; k < 16; ++k) qraw[k] = HQ[(rbase + tg * 16 + k) * HGW + h * HGD + ch];
    u32x2 sgv[4]; f32x4 gv[4];
#pragma unroll
    for (int rg = 0; rg < 4; ++rg) { const int col = h * HGD + 32 * dvb + 8 * rg + 4 * hi; sgv[rg] = *(const u32x2*)(HSG + row * HGW + col); gv[rg] = *(const f32x4*)(ghg + col); }
    float lf[16], bb[16], all, mid;
    hg_front(LOGF, HI, rbase, h, lds, tid, lf, bb, all, mid);
#pragma unroll
    for (int k = 0; k < 16; ++k) { const int t = tg * 16 + k; const float q = bf2f(qraw[k]);
        const float f = ex2(lf[k] * LOG2E); const float e1 = fminf(fmaxf(bb[k] - mid, -80.f), 80.f) * LOG2E;
        *(LAS bf16*)(lds + HG_T0 + t * 256 + ch * 2) = (bf16)f2bf(q * ex2(bb[k] * LOG2E));
        *(LAS bf16*)(lds + HG_T1 + t * 256 + ch * 2) = (bf16)f2bf(q * ex2(e1));
        *(LAS bf16*)(lds + HG_T2 + t * 256 + ch * 2) = (bf16)f2bf((1.0f - f) * ex2(-e1)); }
    __syncthreads();
    f32x16 ot = {};
#pragma unroll
    for (int ks = 0; ks < 8; ++ks)
        ot = MFMA32(sf[ks], *(const LAS bf16x8*)(lds + HG_T0 + (32 * tb + r32) * 256 + (16 * ks + 8 * hi) * 2), ot);
#pragma unroll
    for (int sb = 0; sb < 2; ++sb) {
        if (sb <= tb) {
            f32x16 at = {};
#pragma unroll
            for (int ks = 0; ks < 8; ++ks)
                at = MFMA32(*(const LAS bf16x8*)(lds + HG_T2 + (32 * sb + r32) * 256 + (16 * ks + 8 * hi) * 2), *(const LAS bf16x8*)(lds + HG_T1 + (32 * tb + r32) * 256 + (16 * ks + 8 * hi) * 2), at);
            if (sb == tb) {
#pragma unroll
                for (int r = 0; r < 16; ++r) at[r] = ((r & 3) + 8 * (r >> 2)) <= r32 - 4 * hi ? at[r] : 0.f;
            }
            const bf16x8 p0 = acc_frag<0>(at), p1 = acc_frag<1>(at);
            ot = MFMA32(trfrag(lds + HG_T3, 256, 32 * dvb, 32 * sb + 4 * hi, 32 * sb + 8 + 4 * hi, lane), p0, ot);
            ot = MFMA32(trfrag(lds + HG_T3, 256, 32 * dvb, 32 * sb + 16 + 4 * hi, 32 * sb + 24 + 4 * hi, lane), p1, ot);
        }
    }
    float ssq = 0.f;
#pragma unroll
    for (int r = 0; r < 16; ++r) ssq += ot[r] * ot[r];
    ssq += __shfl_xor(ssq, 32);
    LAS float* SSQ = (LAS float*)(lds + HG_SSQ);
    if (hi == 0) SSQ[dvb * 64 + tl] = ssq;
    __syncthreads();
    const float rstd = __builtin_amdgcn_rsqf(((SSQ[tl] + SSQ[64 + tl]) + (SSQ[128 + tl] + SSQ[192 + tl])) * (1.0f / (float)HGD) + EPS);
#pragma unroll
    for (int rg = 0; rg < 4; ++rg) { const int col = h * HGD + 32 * dvb + 8 * rg + 4 * hi; const f32x4 g = gv[rg]; const u32x2 sg = sgv[rg];
        u32x2 w; w.x = cvtpk(ot[4 * rg] * rstd * g[0] * bf_lo(sg.x), ot[4 * rg + 1] * rstd * g[1] * bf_hi(sg.x)); w.y = cvtpk(ot[4 * rg + 2] * rstd * g[2] * bf_lo(sg.y), ot[4 * rg + 3] * rstd * g[3] * bf_hi(sg.y));
        *(u32x2*)(MIXED + row * D + col) = w; }
    __syncthreads();
}

struct Args { const float* in[20]; float* out; unsigned char* ws; int ph_lo, ph_hi; };

__device__ __forceinline__ void transpose_item(const float* W, int K, int N, bf16* WT, const float* gain, int mode, LAS float* scr, int item, int lane) {
    const int nblk = N / 32, kb = item / nblk, nb = item % nblk, k0 = 64 * kb, n0 = 32 * nb;
#pragma unroll 8
    for (int i = 0; i < 32; ++i) { const int kk = 2 * i + (lane >> 5); const float g = gain ? gain[k0 + kk] : 1.0f; scr[kk * 33 + (lane & 31)] = W[(size_t)(k0 + kk) * N + n0 + (lane & 31)] * g; }
    LDS_WAIT(); asm volatile("" ::: "memory");
    int orow0 = n0;
    if (mode == 1) { const int j = n0 < FF ? n0 : n0 - FF; orow0 = (j >> 7) * 256 + (n0 < FF ? 0 : 128) + (j & 127); }
    const int c = lane & 7;
#pragma unroll
    for (int j = 0; j < 4; ++j) { const int n = (lane >> 3) + 8 * j; const LAS float* s = scr + (8 * c) * 33 + n;
        v4u o; o.x = pk2(s[0 * 33], s[1 * 33]); o.y = pk2(s[2 * 33], s[3 * 33]); o.z = pk2(s[4 * 33], s[5 * 33]); o.w = pk2(s[6 * 33], s[7 * 33]);
        *(GAS v4u*)(WT + (size_t)(orow0 + n) * K + k0 + 8 * c) = o; }
    LDS_WAIT(); asm volatile("" ::: "memory");
}

__global__ void __launch_bounds__(NWAVES * 64, 2) layer_fwd(Args args) {
    extern __shared__ __attribute__((aligned(16))) unsigned char lds_raw[];
    LAS unsigned char* lds = (LAS unsigned char*)lds_raw;
    volatile LAS unsigned* MISC = (volatile LAS unsigned*)(lds + MISC_OFF);
    const int tid = threadIdx.x, lane = tid & 63, wave = __builtin_amdgcn_readfirstlane(tid >> 6);
    const int G = gridDim.x, bx = blockIdx.x;
    const int vcu = (G % 8 == 0) ? (bx % 8) * (G / 8) + bx / 8 : bx;
    unsigned char* ws = args.ws;
    gu32* ctl = (gu32*)(ws + WS_CTL);
    float* ss0 = (float*)(ws + WS_SS); float* ss1 = ss0 + M; float* ss2 = ss1 + M; float* ss3 = ss2 + M;
    bf16* Wgu1 = (bf16*)(ws + WS_WGU1); bf16* Wd1 = (bf16*)(ws + WS_WD1); bf16* Win = (bf16*)(ws + WS_WIN); bf16* Wout = (bf16*)(ws + WS_WOUT);
    bf16* Wq = (bf16*)(ws + WS_WQ); bf16* Wkv = (bf16*)(ws + WS_WKV); bf16* Wo = (bf16*)(ws + WS_WO); bf16* Wgu2 = (bf16*)(ws + WS_WGU2); bf16* Wd2 = (bf16*)(ws + WS_WD2);
    bf16* MN = (bf16*)(ws + WS_MN); bf16* KMEM = (bf16*)(ws + WS_KMEM); bf16* VT = (bf16*)(ws + WS_VT);
    bf16* XB = (bf16*)(ws + WS_XB); bf16* HMID = (bf16*)(ws + WS_HMID);
    bf16* HQ = (bf16*)(ws + WS_HQ); float* LOGF = (float*)(ws + WS_LOGF); bf16* HI = (bf16*)(ws + WS_HI); bf16* HSG = (bf16*)(ws + WS_HSG);
    bf16* SBQ = (bf16*)(ws + WS_SBQ); bf16* SBK = (bf16*)(ws + WS_SBK); bf16* SBV = (bf16*)(ws + WS_SBV);
    bf16* MIXED = (bf16*)(ws + WS_MIXED); bf16* STb = (bf16*)args.out;     float* DVEC = (float*)(ws + WS_DVEC); bf16* QC = (bf16*)(ws + WS_QC); bf16* PMb = (bf16*)(ws + WS_PM); bf16* OC = (bf16*)(ws + WS_OC);
    const float* x_in = args.in[0]; float* out = args.out;

    for (int u = tid; u < (LDS_BYTES - LDSCTL_OFF) / 4; u += NWAVES * 64) ((LAS unsigned*)(lds + LDSCTL_OFF))[u] = 0u;
    __syncthreads();
#if MK_ONE_LAUNCH
    XcdBarrier bar = xcd_barrier_post((unsigned*)(ctl + CW_BAR), MISC + 8);
#define GRID_BAR() xcd_barrier(bar)
#else
#define GRID_BAR() do { } while (0)
#endif
    const int lo = args.ph_lo, hi = args.ph_hi;
#define IN(k) (lo <= (k) && (k) < hi)
#ifdef PROBE_PHASE
    unsigned long long* stampw = (unsigned long long*)(ws + WS_CTL + 65536);
#define STAMP(k) do { if (bx == 0 && tid == 0) stampw[(k) + 1] = __builtin_amdgcn_s_memrealtime(); } while (0)
    if (bx == 0 && tid == 0) stampw[0] = __builtin_amdgcn_s_memrealtime();
#else
#define STAMP(k) do { } while (0)
#endif
#define SEAM(k) do { if (IN(k) && IN((k) + 1)) GRID_BAR(); STAMP(k); } while (0)
    const int gw = vcu * NWAVES + wave, NGW = G * NWAVES;

    if (IN(0)) {
        LAS float* scr = (LAS float*)(lds + wave * 16384);
        constexpr int I_GU = (D / 64) * (GU / 32), I_DN = (FF / 64) * (D / 32), I_IN = (D / 64) * (INC / 32), I_SQ = (D / 64) * (D / 32), I_KV = (D / 64) * (2 * D / 32);
        constexpr int NITEMS = 2 * I_GU + 2 * I_DN + I_IN + 3 * I_SQ + I_KV;
        for (int it = gw; it < NITEMS; it += NGW) {
            int r = it;
            if (r < I_GU) { transpose_item(args.in[3], D, GU, Wgu1, args.in[2], 1, scr, r, lane); continue; } r -= I_GU;
            if (r < I_GU) { transpose_item(args.in[17], D, GU, Wgu2, args.in[16], 1, scr, r, lane); continue; } r -= I_GU;
            if (r < I_DN) { transpose_item(args.in[4], FF, D, Wd1, nullptr, 0, scr, r, lane); continue; } r -= I_DN;
            if (r < I_DN) { transpose_item(args.in[18], FF, D, Wd2, nullptr, 0, scr, r, lane); continue; } r -= I_DN;
            if (r < I_IN) { transpose_item(args.in[6], D, INC, Win, args.in[5], 0, scr, r, lane); continue; } r -= I_IN;
            if (r < I_SQ) { transpose_item(args.in[10], D, D, Wout, nullptr, 0, scr, r, lane); continue; } r -= I_SQ;
            if (r < I_SQ) { transpose_item(args.in[13], D, D, Wq, args.in[11], 0, scr, r, lane); continue; } r -= I_SQ;
            if (r < I_SQ) { transpose_item(args.in[15], D, D, Wo, nullptr, 0, scr, r, lane); continue; } r -= I_SQ;
            transpose_item(args.in[14], D, 2 * D, Wkv, nullptr, 0, scr, r, lane);
        }
        for (int m = gw; m < M; m += NGW) {
            const GAS f32x4* xr = (const GAS f32x4*)(x_in + (size_t)m * D) + lane; f32x4 v[4]; float s = 0.f;
#pragma unroll
            for (int j = 0; j < 4; ++j) { v[j] = xr[64 * j]; s += (v[j].x * v[j].x + v[j].y * v[j].y) + (v[j].z * v[j].z + v[j].w * v[j].w); }
            s = wave_sum(s);
            GAS unsigned long long* o8 = (GAS unsigned long long*)(XB + (size_t)m * D) + lane;
#pragma unroll
            for (int j = 0; j < 4; ++j) o8[64 * j] = (unsigned long long)pk2(v[j].x, v[j].y) | ((unsigned long long)pk2(v[j].z, v[j].w) << 32);
            if (lane == 0) ss0[m] = s;
        }
        for (int m = gw; m < MROWS; m += NGW) {
            const GAS f32x4* xr = (const GAS f32x4*)(args.in[1] + (size_t)m * D) + lane; const GAS f32x4* gr = (const GAS f32x4*)(args.in[12]) + lane; f32x4 v[4]; float s = 0.f;
#pragma unroll
            for (int j = 0; j < 4; ++j) { v[j] = xr[64 * j]; s += (v[j].x * v[j].x + v[j].y * v[j].y) + (v[j].z * v[j].z + v[j].w * v[j].w); }
            const float r = __builtin_amdgcn_rsqf(wave_sum(s) * (1.0f / (float)D) + EPS);
            GAS unsigned long long* o8 = (GAS unsigned long long*)(MN + (size_t)m * D) + lane;
#pragma unroll
            for (int j = 0; j < 4; ++j) { const f32x4 g = gr[64 * j]; o8[64 * j] = (unsigned long long)pk2(v[j].x * r * g.x, v[j].y * r * g.y) | ((unsigned long long)pk2(v[j].z * r * g.z, v[j].w * r * g.w) << 32); }
        }
    }
    SEAM(0);
    if (IN(1)) { pg8::TileOrder S; S.init(XB, Wgu1, D, D, M, GU, G, bx); EpiSwiglu E{HMID, ss0}; pg8::gemm_phase(lds, D, D, D, S, E); }
    SEAM(1);
    if (IN(2)) { pg8::TileOrder S; S.init(HMID, Wd1, FF, FF, M, D, G, bx); EpiResid<true> E{x_in, nullptr, XB, ss1, 0.5f}; pg8::gemm_phase(lds, FF, FF, FF, S, E); }
    SEAM(2);
    if (IN(3)) { pg8::TileOrder S; S.init(XB, Win, D, D, M, INC, G, bx); EpiWin E{ss1, args.in[7], HQ, LOGF, HI, HSG, SBQ, SBK, SBV}; pg8::gemm_phase(lds, D, D, D, S, E); }
    SEAM(3);
    if (IN(4)) {
        for (int it = bx; it < BATCH * HGH * (SEQ / 64); it += G) hg_pass1(LOGF, HI, STb, DVEC, it, lds, tid, wave, lane);
        for (int T = bx; T < BATCH * SBH * (SEQ / 256); T += G)
            sb_qblock(SBQ, SBK, SBV, args.in[9], MIXED, T >> 5, (T & 31) * 8 + wave, lds + wave * 8192, lane);
    }
    SEAM(4);
    if (IN(5)) {
        if (bx < 16) {
            const int L = bx; OneUnit S{(const char*)(MN + (size_t)(L >> 2) * 256 * D), (const char*)(Wkv + (size_t)(L & 3) * 256 * D), L >> 2, L & 3};
            EpiPlain E{KMEM, D, nullptr, 1.0f}; pg8::gemm_phase(lds, D, D, D, S, E);
        } else if (bx < 32) {
            const int L = bx - 16; OneUnit S{(const char*)(Wkv + (size_t)(D + (L >> 2) * 256) * D), (const char*)(MN + (size_t)(L & 3) * 256 * D), L >> 2, L & 3};
            EpiPlain E{VT, D, nullptr, 1.0f}; pg8::gemm_phase(lds, D, D, D, S, E);
        } else {
            const int gid = (bx - 32) * 512 + tid;
            if (gid < BATCH * HGH * HGD * HGD / 4) {
                const int bh = gid >> 12, e = (gid & 4095) * 4, dk = e & 127;
                bf16* sp = STb + (size_t)bh * 128 * (HGD * HGD) + e; const float* dp = DVEC + (size_t)bh * 128 * HGD + dk;
                f32x4 Sv = {0.f, 0.f, 0.f, 0.f};
                for (int c0 = 0; c0 < 128; c0 += 8) {
                    u32x2 u[8]; f32x4 dd[8];
#pragma unroll
                    for (int j = 0; j < 8; ++j) { u[j] = *(const u32x2*)(sp + (size_t)(c0 + j) * (HGD * HGD)); dd[j] = *(const f32x4*)(dp + (size_t)(c0 + j) * HGD); }
#pragma unroll
                    for (int j = 0; j < 8; ++j) { u32x2 o; o.x = cvtpk(Sv[0], Sv[1]); o.y = cvtpk(Sv[2], Sv[3]); *(u32x2*)(sp + (size_t)(c0 + j) * (HGD * HGD)) = o;
                        Sv[0] = dd[j][0] * Sv[0] + bf_lo(u[j].x); Sv[1] = dd[j][1] * Sv[1] + bf_hi(u[j].x); Sv[2] = dd[j][2] * Sv[2] + bf_lo(u[j].y); Sv[3] = dd[j][3] * Sv[3] + bf_hi(u[j].y); }
                }
            }
        }
    }
    SEAM(5);
    if (IN(6)) { for (int it = bx; it < BATCH * HGH * (SEQ / 64); it += G) hg_pass3(LOGF, HQ, HI, HSG, STb, args.in[8], MIXED, it, lds, tid, wave, lane); }
    SEAM(6);
    if (IN(7)) { pg8::TileOrder S; S.init(MIXED, Wout, D, D, M, D, G, bx); EpiResid<false> E{XB, nullptr, XB, ss2, 1.0f}; pg8::gemm_phase(lds, D, D, D, S, E); }
    SEAM(7);
    if (IN(8)) { pg8::TileOrder S; S.init(XB, Wq, D, D, M, D, G, bx); EpiPlain E{QC, D, ss2, CA_QSCALE}; pg8::gemm_phase(lds, D, D, D, S, E); }
    SEAM(8);
    if (IN(9)) { CrossOrder S{(const char*)QC, (const char*)KMEM, G, bx, 0}; EpiSoftmax E{PMb, lds + EPI_OFF}; int kc = CHD; asm volatile("" : "+s"(kc)); pg8::gemm_phase(lds, kc, D, D, S, E); }
    SEAM(9);
    if (IN(10)) { CrossOrder S{(const char*)PMb, (const char*)VT, G, bx, 1}; EpiPlain E{OC, D, nullptr, 1.0f}; int kc = NMEM; asm volatile("" : "+s"(kc)); pg8::gemm_phase(lds, kc, D, D, S, E); }
    SEAM(10);
    if (IN(11)) { pg8::TileOrder S; S.init(OC, Wo, D, D, M, D, G, bx); EpiResid<false> E{XB, nullptr, XB, ss3, 1.0f}; pg8::gemm_phase(lds, D, D, D, S, E); }
    SEAM(11);
    if (IN(12)) { pg8::TileOrder S; S.init(XB, Wgu2, D, D, M, GU, G, bx); EpiSwiglu E{HMID, ss3}; pg8::gemm_phase(lds, D, D, D, S, E); }
    SEAM(12);
    if (IN(13)) { pg8::TileOrder S; S.init(HMID, Wd2, FF, FF, M, D, G, bx); EpiResid<false> E{XB, out, nullptr, nullptr, 0.5f}; pg8::gemm_phase(lds, FF, FF, FF, S, E); }
    SEAM(13);
    if (IN(14)) {
        const GAS f32x4* gr = (const GAS f32x4*)(args.in[19]) + lane;
        for (int m = gw; m < M; m += NGW) {
            GAS f32x4* xr = (GAS f32x4*)(out + (size_t)m * D) + lane; f32x4 v[4]; float s = 0.f;
#pragma unroll
            for (int j = 0; j < 4; ++j) { v[j] = xr[64 * j]; s += (v[j].x * v[j].x + v[j].y * v[j].y) + (v[j].z * v[j].z + v[j].w * v[j].w); }
            const float r = __builtin_amdgcn_rsqf(wave_sum(s) * (1.0f / (float)D) + EPS);
#pragma unroll
            for (int j = 0; j < 4; ++j) { const f32x4 g = gr[64 * j]; xr[64 * j] = v[j] * r * g; }
        }
    }
#ifdef PROBE_PHASE
    if (bx == 0) { VM_WAIT(); __syncthreads(); if (tid == 0) { stampw[15] = __builtin_amdgcn_s_memrealtime();
        const unsigned long long dt = (PROBE_PHASE >= 90) ? stampw[15] - stampw[0] : stampw[PROBE_PHASE + 1] - stampw[PROBE_PHASE];
        out[0] += (float)dt * 0.01f * (PROBE_PHASE >= 90 ? 0.002f : 0.01f); } }
#endif
#undef IN
#undef SEAM
}

constexpr int N_PHASES = 15;
extern "C" void kernel_launch(void* const* d_in, const int* in_sizes, int n_in, void* d_out, int out_size, void* d_ws, size_t ws_size, hipStream_t stream) {
    static int grid = 0;
    if (grid == 0) {
        if (n_in != 20 || in_sizes[0] != M * D || out_size != M * D || ws_size < WS_END) { fprintf(stderr, "kernel_launch: unexpected shapes (n_in %d, in0 %d, out %d, ws %zu)\n", n_in, n_in > 0 ? in_sizes[0] : -1, out_size, ws_size); grid = -1; return; }
        int dev = 0, cus = 0;
        if (hipGetDevice(&dev) != hipSuccess || hipDeviceGetAttribute(&cus, hipDeviceAttributeMultiprocessorCount, dev) != hipSuccess) { grid = -1; return; }
        if (hipFuncSetAttribute((const void*)layer_fwd, hipFuncAttributeMaxDynamicSharedMemorySize, LDS_BYTES) != hipSuccess) { fprintf(stderr, "kernel_launch: hipFuncSetAttribute failed\n"); grid = -1; return; }
        int per_cu = 0;
        if (hipOccupancyMaxActiveBlocksPerMultiprocessor(&per_cu, (const void*)layer_fwd, NWAVES * 64, LDS_BYTES) != hipSuccess || per_cu < 1) fprintf(stderr, "kernel_launch: occupancy query says %d\n", per_cu);
        (void)hipGetLastError();
        grid = cus;
    }
    if (grid < 0) return;
    if (hipMemsetAsync((char*)d_ws + WS_CTL, 0, CTL_ZERO_BYTES, stream) != hipSuccess) return;
    Args a{};
    for (int i = 0; i < 20; ++i) a.in[i] = (const float*)d_in[i];
    a.out = (float*)d_out; a.ws = (unsigned char*)d_ws;
#if MK_ONE_LAUNCH
    a.ph_lo = 0; a.ph_hi = N_PHASES;
    hipLaunchKernelGGL(layer_fwd, dim3(grid), dim3(NWAVES * 64), LDS_BYTES, stream, a);
#else
    for (int p = 0; p < N_PHASES; ++p) { a.ph_lo = p; a.ph_hi = p + 1; hipLaunchKernelGGL(layer_fwd, dim3(grid), dim3(NWAVES * 64), LDS_BYTES, stream, a); }
#endif
}
```

```cpp
#include <hip/hip_runtime.h>
#include <cstdio>
#include <cstdint>

#ifndef MK_ONE_LAUNCH
#define MK_ONE_LAUNCH 1
#endif

namespace pg8 {
#define PG8_LAS __attribute__((address_space(3)))
typedef unsigned short bf16_t;
typedef short bf16x8 __attribute__((ext_vector_type(8)));
typedef float f32x4 __attribute__((ext_vector_type(4)));
typedef float f32x2 __attribute__((ext_vector_type(2)));
typedef unsigned u32x4 __attribute__((ext_vector_type(4)));
constexpr int BM = 256, BK = 64, HALF = 128, HTB = HALF * BK * 2, STAGE_BYTES = 8 * HTB, NXCD = 8, WGM = 8;

__host__ __device__ __forceinline__ int lds_byte(int r, int c) { const int st = (r >> 4) * 2 + (c >> 5), rr = r & 15, cc = c & 31, ob = rr * 64 + cc * 2; return st * 1024 + (ob ^ (((ob >> 9) & 1) << 5)); }
__host__ __device__ __forceinline__ void stage_rc(int b, int& R, int& C) { const int st = b / 1024, sb = b % 1024, swz = sb ^ (((sb >> 9) & 1) << 5); R = (st >> 1) * 16 + swz / 64; C = (st & 1) * 32 + (swz % 64) / 2; }
__host__ __device__ __forceinline__ int perm32(int rho) { const int n = rho >> 4, i = rho & 15; return 8 * (i >> 2) + 4 * n + (i & 3); }

struct Unit { int pm, pn; const char* a; const char* b; };

__device__ __forceinline__ unsigned cvt_pk_bf16(float lo, float hi) { unsigned r; asm volatile("v_cvt_pk_bf16_f32 %0, %1, %2" : "=v"(r) : "v"(lo), "v"(hi)); return r; }

struct TileOrder {
    const char* A; const char* B; int lda, ldb; int nM, nN, nwg, G, c;
    __device__ __forceinline__ void init(const void* A_, const void* B_, int lda_, int ldb_, int M, int N, int G_, int c_) { A = (const char*)A_; B = (const char*)B_; lda = lda_; ldb = ldb_; nM = M / BM; nN = N / BM; nwg = nM * nN; G = G_; c = c_; }
    __device__ __forceinline__ bool next(int i, Unit& u) const {
        const long L = (long)i * G + c; if (L >= nwg) return false;
        int wgid = (int)L; { const int q = nwg / NXCD, r = nwg % NXCD, xcd = wgid % NXCD, off = wgid / NXCD; wgid = (xcd < r ? xcd * (q + 1) : r * (q + 1) + (xcd - r) * q) + off; }
        const int nig = WGM * nN, gid = wgid / nig, fm = gid * WGM, gsz = (nM - fm) < WGM ? (nM - fm) : WGM;
        u.pm = fm + ((wgid % nig) % gsz); u.pn = (wgid % nig) / gsz;
        u.a = A + (size_t)u.pm * BM * lda * 2; u.b = B + (size_t)u.pn * BM * ldb * 2; return true;
    }
};

template <class Epi, class Sched>
__device__ __forceinline__ void gemm_phase(PG8_LAS unsigned char* lds, const int K, const int lda, const int ldb, const Sched& S, const Epi& E) {
    const int tid = threadIdx.x, wid = __builtin_amdgcn_readfirstlane(tid >> 6), lane = tid & 63, wr = wid >> 2, wc = wid & 3, fr = lane & 15, fq = lane >> 4;
    const int nt = K / BK;
    unsigned voffA[2], voffB[2];
#pragma unroll
    for (int i = 0; i < 2; ++i) { int R, C; stage_rc(tid * 16 + i * 8192, R, C); const int Rb = Epi::PERM ? ((R & ~31) + perm32(R & 31)) : R;
        voffA[i] = (unsigned)(R * lda + C) * 2u; voffB[i] = (unsigned)(Rb * ldb + C) * 2u; }
    const size_t kstep = (size_t)(BK * 2);
    const size_t hstepA = (size_t)HALF * lda * 2, hstepB = (size_t)HALF * ldb * 2;
    const unsigned ldsw = (unsigned)wid * 1024u;
    const int aoff = lds_byte(wr * 64 + fr, fq * 8), boff = lds_byte(wc * 32 + fr, fq * 8);
#define PG8_SA(b, h) (((b) * 2 + (h)) * HTB)
#define PG8_SB(b, h) ((4 + (b) * 2 + (h)) * HTB)
#define PG8_STAGE(bufoff, gbase, voff) do { _Pragma("unroll") for (int _i = 0; _i < 2; ++_i) \
        __builtin_amdgcn_global_load_lds((const unsigned*)((const char*)(gbase) + (voff)[_i]), (PG8_LAS unsigned*)(lds + (bufoff) + ldsw + _i * 8192), 16, 0, 0); } while (0)
#define PG8_LDA(dst, b, h) do { _Pragma("unroll") for (int m = 0; m < 4; ++m) _Pragma("unroll") for (int k = 0; k < 2; ++k) dst[m][k] = *(const PG8_LAS bf16x8*)(lds + PG8_SA(b, h) + aoff + m * 2048 + k * 1024); } while (0)
#define PG8_LDB(dst, b, h) do { _Pragma("unroll") for (int n = 0; n < 2; ++n) _Pragma("unroll") for (int k = 0; k < 2; ++k) dst[n][k] = *(const PG8_LAS bf16x8*)(lds + PG8_SB(b, h) + boff + n * 2048 + k * 1024); } while (0)
#define PG8_MMA(ai, bj, At, Bt) do { __builtin_amdgcn_s_setprio(1); _Pragma("unroll") for (int m = 0; m < 4; ++m) _Pragma("unroll") for (int n = 0; n < 2; ++n) _Pragma("unroll") for (int k = 0; k < 2; ++k) \
        acc[ai][bj][m][n] = __builtin_amdgcn_mfma_f32_16x16x32_bf16(Bt[n][k], At[m][k], acc[ai][bj][m][n], 0, 0, 0); __builtin_amdgcn_s_setprio(0); } while (0)
#define PG8_WAIT_V(n) asm volatile("s_waitcnt vmcnt(" #n ")" ::: "memory")
#define PG8_WAIT_L(n) asm volatile("s_waitcnt lgkmcnt(" #n ")" ::: "memory")
#define PG8_BAR __builtin_amdgcn_s_barrier()
#define PG8_SCHED __builtin_amdgcn_sched_barrier(0)
    Unit cur, nxt; int ui = 0;
    if (!S.next(0, cur)) return;
    f32x4 acc[2][2][4][2];
#pragma unroll
    for (int a = 0; a < 2; ++a)
#pragma unroll
        for (int b = 0; b < 2; ++b)
#pragma unroll
            for (int m = 0; m < 4; ++m)
#pragma unroll
                for (int n = 0; n < 2; ++n) acc[a][b][m][n] = (f32x4){0.f, 0.f, 0.f, 0.f};
    bf16x8 At[4][2], B0[2][2], B1[2][2];
    const char* cA = cur.a; const char* cB = cur.b;
    PG8_STAGE(PG8_SB(0, 0), cB, voffB); PG8_STAGE(PG8_SB(0, 1), cB + hstepB, voffB); PG8_STAGE(PG8_SA(0, 0), cA, voffA); PG8_STAGE(PG8_SA(0, 1), cA + hstepA, voffA);
    if (wr == 1) PG8_BAR;
    PG8_WAIT_V(2); PG8_BAR;
    PG8_STAGE(PG8_SB(1, 0), cB + kstep, voffB); PG8_STAGE(PG8_SA(1, 0), cA + kstep, voffA); PG8_STAGE(PG8_SB(1, 1), cB + hstepB + kstep, voffB);
    PG8_WAIT_V(6); PG8_BAR;
    for (;;) {
        const bool has_next = S.next(ui + 1, nxt);
        const char* nA = has_next ? nxt.a : cA; const char* nB = has_next ? nxt.b : cB;
        for (int t = 0; t < nt; t += 2) {
            const bool last = (t == nt - 2);
            const char* a1 = cA + (size_t)(t + 1) * kstep;
            const char* a2 = last ? nA : cA + (size_t)(t + 2) * kstep; const char* b2 = last ? nB : cB + (size_t)(t + 2) * kstep;
            const char* a3 = a2 + kstep; const char* b3 = b2 + kstep;
            PG8_LDB(B0, 0, 0); PG8_LDB(B1, 0, 1); PG8_SCHED; PG8_LDA(At, 0, 0); PG8_STAGE(PG8_SA(1, 1), a1 + hstepA, voffA);
            PG8_WAIT_V(8); PG8_WAIT_L(0); PG8_BAR; PG8_MMA(0, 0, At, B0); PG8_MMA(0, 1, At, B1); PG8_BAR; PG8_SCHED;
            PG8_LDA(At, 0, 1); PG8_STAGE(PG8_SB(0, 0), b2, voffB); PG8_STAGE(PG8_SB(0, 1), b2 + hstepB, voffB); PG8_STAGE(PG8_SA(0, 0), a2, voffA);
            PG8_WAIT_V(8); PG8_WAIT_L(0); PG8_BAR; PG8_MMA(1, 0, At, B0); PG8_MMA(1, 1, At, B1); PG8_BAR; PG8_SCHED;
            PG8_LDB(B0, 1, 0); PG8_LDB(B1, 1, 1); PG8_SCHED; PG8_LDA(At, 1, 0); PG8_STAGE(PG8_SA(0, 1), a2 + hstepA, voffA);
            PG8_WAIT_V(8); PG8_WAIT_L(0); PG8_BAR; PG8_MMA(0, 0, At, B0); PG8_MMA(0, 1, At, B1); PG8_BAR; PG8_SCHED;
            PG8_LDA(At, 1, 1); PG8_STAGE(PG8_SB(1, 0), b3, voffB); PG8_STAGE(PG8_SB(1, 1), b3 + hstepB, voffB); PG8_STAGE(PG8_SA(1, 0), a3, voffA);
            PG8_WAIT_V(8); PG8_WAIT_L(0); PG8_BAR; PG8_MMA(1, 0, At, B0); PG8_MMA(1, 1, At, B1); PG8_BAR; PG8_SCHED;
        }
        if (wr == 0) PG8_BAR;
        E(acc, cur, wr, wc, fr, fq, wid, lane);
        if (!has_next) break;
#pragma unroll
        for (int a = 0; a < 2; ++a)
#pragma unroll
            for (int b = 0; b < 2; ++b)
#pragma unroll
                for (int m = 0; m < 4; ++m)
#pragma unroll
                    for (int n = 0; n < 2; ++n) acc[a][b][m][n] = (f32x4){0.f, 0.f, 0.f, 0.f};
        cur = nxt; cA = nA; cB = nB; ++ui;
        if (wr == 1) PG8_BAR;
    }
    PG8_WAIT_V(0);
    PG8_BAR;
#undef PG8_SA
#undef PG8_SB
#undef PG8_STAGE
#undef PG8_LDA
#undef PG8_LDB
#undef PG8_MMA
#undef PG8_WAIT_V
#undef PG8_WAIT_L
#undef PG8_BAR
#undef PG8_SCHED
}
}

constexpr int NWAVES = 8;
constexpr int BATCH = 4, SEQ = 8192, D = 1024, M = BATCH * SEQ;
constexpr int FF = 2816, GU = 2 * FF, INC = 3584, NMEM = 256, MROWS = BATCH * NMEM;
constexpr int HGW = 512, HGH = 4, HGD = 128, SBW = 512, SBH = 8, SBD = 64, CHD = 256;
constexpr float EPS = 1e-6f, LOG2E = 1.4426950408889634f, LN2 = 0.6931471805599453f;
constexpr float SB_QSCALE = 0.125f * LOG2E;
constexpr float CA_QSCALE = 0.0625f * LOG2E;
constexpr float SB_STOP = 128.0f;

constexpr size_t MiB = 1u << 20;
constexpr size_t WS_CTL = 0, CTL_ZERO_BYTES = 2 * MiB;
constexpr size_t WS_SS = 1 * MiB;
constexpr size_t WS_WGU1 = 2 * MiB, WS_WD1 = 13 * MiB, WS_WIN = 19 * MiB, WS_WOUT = 26 * MiB, WS_WQ = 28 * MiB, WS_WKV = 30 * MiB, WS_WO = 34 * MiB, WS_WGU2 = 36 * MiB, WS_WD2 = 47 * MiB;
constexpr size_t WS_MN = 53 * MiB, WS_KMEM = 55 * MiB, WS_VT = 57 * MiB, WS_DVEC = 59 * MiB;
constexpr size_t WS_XB = 64 * MiB;
constexpr size_t WS_HMID = 128 * MiB;
constexpr size_t WS_HQ = 128 * MiB, WS_LOGF = 160 * MiB, WS_HI = 224 * MiB, WS_HSG = 256 * MiB;
constexpr size_t WS_SBQ = 304 * MiB, WS_SBK = 336 * MiB, WS_SBV = 368 * MiB;
constexpr size_t WS_MIXED = 400 * MiB;
constexpr size_t WS_QC = 128 * MiB, WS_PM = 192 * MiB, WS_OC = 304 * MiB;
constexpr size_t WS_END = 464 * MiB;
constexpr int CW_TMO = 0, CW_CODE = 1, CW_BAR = 4096;

constexpr int RING_BYTES = 131072;
constexpr int LDSCTL_OFF = RING_BYTES, MISC_OFF = LDSCTL_OFF + 320;
constexpr int EPI_OFF = RING_BYTES + 1024;
constexpr int LDS_BYTES = 147456;

#define GAS __attribute__((address_space(1)))
#define LAS __attribute__((address_space(3)))
typedef unsigned short bf16;
typedef unsigned v4u __attribute__((ext_vector_type(4)));
typedef float f32x4 __attribute__((ext_vector_type(4)));
typedef GAS unsigned gu32;
#define RLX_AGENT __ATOMIC_RELAXED, __HIP_MEMORY_SCOPE_AGENT
#define LDS_WAIT() asm volatile("s_waitcnt lgkmcnt(0)" ::: "memory")
#define VM_WAIT() asm volatile("s_waitcnt vmcnt(0)" ::: "memory")
__device__ __forceinline__ unsigned f2bf(float f) { unsigned u = __builtin_bit_cast(unsigned, f); return (u + 0x7fffu + ((u >> 16) & 1u)) >> 16; }
__device__ __forceinline__ unsigned pk2(float lo, float hi) { return f2bf(lo) | (f2bf(hi) << 16); }
__device__ __forceinline__ float bf_lo(unsigned w) { return __builtin_bit_cast(float, w << 16); }
__device__ __forceinline__ float bf_hi(unsigned w) { return __builtin_bit_cast(float, w & 0xffff0000u); }
__device__ __forceinline__ float bf2f(bf16 h) { return __builtin_bit_cast(float, (unsigned)h << 16); }
__device__ __forceinline__ float ex2(float x) { return __builtin_amdgcn_exp2f(x); }
__device__ __forceinline__ float lg2(float x) { return __builtin_amdgcn_logf(x); }
__device__ __forceinline__ float rcpf_(float x) { return __builtin_amdgcn_rcpf(x); }
__device__ __forceinline__ float sigmoidf_(float v) { return rcpf_(1.0f + ex2(-v * LOG2E)); }
__device__ __forceinline__ float siluf_(float v) { return v * sigmoidf_(v); }
__device__ __forceinline__ float rdlane(float v, int l) { return __builtin_bit_cast(float, __builtin_amdgcn_readlane(__builtin_bit_cast(int, v), l)); }
__device__ __forceinline__ float wave_sum(float v) {
#pragma unroll
    for (int o = 1; o < 64; o <<= 1) v += __shfl_xor(v, o);
    return v;
}

#define XB_TMO      128
#define XB_XCNT(j)  (256  + 64 * (j))
#define XB_XSUB(j)  (1280 + 64 * (j))
#define XB_XGEN(j)  (2304 + 64 * (j))
#define XB_TOP      3328
#define XB_TOPGEN   3392
#define XCD_BAR_WORDS 3456
#define XB_SPIN_CAP (1u << 18)
__device__ __forceinline__ unsigned xb_ld(unsigned* p)              { return __hip_atomic_load(p, __ATOMIC_RELAXED, __HIP_MEMORY_SCOPE_AGENT); }
__device__ __forceinline__ unsigned xb_add(unsigned* p, unsigned v) { return __hip_atomic_fetch_add(p, v, __ATOMIC_RELAXED, __HIP_MEMORY_SCOPE_AGENT); }
__device__ __forceinline__ unsigned xb_xcc_id() { return (unsigned)__builtin_amdgcn_s_getreg((3 << 11) | 20) & 0xFu; }
#define XB_SPIN(cond, bar) do { unsigned _sp = 0; while (cond) { __builtin_amdgcn_s_sleep(1); \
    if ((++_sp & 255u) == 0u) { if (xb_ld(&(bar)[XB_TMO])) break; if (_sp > XB_SPIN_CAP) { atomicAdd(&(bar)[XB_TMO], 1u); break; } } } } while (0)
struct XcdBarrier { unsigned* bar; unsigned x; volatile LAS unsigned* st; };
__device__ __forceinline__ XcdBarrier xcd_barrier_post(unsigned* bar, volatile LAS unsigned* st) {
    XcdBarrier b; b.bar = bar; b.x = xb_xcc_id(); b.st = st;
    if (threadIdx.x == 0) (void)xb_add(&bar[XB_XCNT(b.x)], 1u);
    return b;
}
__device__ __forceinline__ void xcd_barrier_complete(unsigned* bar, unsigned x, unsigned& nloc, unsigned& nx) {
    const unsigned G = gridDim.x * gridDim.y * gridDim.z;
    unsigned sum, cnt, mine, sp = 0u;
    for (;;) {
        sum = 0u; cnt = 0u; mine = 0u;
#pragma unroll
        for (unsigned j = 0; j < 16; ++j) { const unsigned c = xb_ld(&bar[XB_XCNT(j)]); sum += c; cnt += (c > 0u) ? 1u : 0u; mine = (j == x) ? c : mine; }
        if (sum == G) break;
        __builtin_amdgcn_s_sleep(1);
        if ((++sp & 255u) == 0u) { if (xb_ld(&bar[XB_TMO])) break; if (sp > XB_SPIN_CAP) { atomicAdd(&bar[XB_TMO], 1u); break; } }
    }
    nloc = mine > 0u ? mine : 1u; nx = cnt > 0u ? cnt : 1u;
}
__device__ __forceinline__ void xcd_barrier(const XcdBarrier& b) {
    asm volatile("s_waitcnt vmcnt(0)" ::: "memory");
    __syncthreads();
    if (threadIdx.x == 0) {
        unsigned* bar = b.bar;
        __builtin_amdgcn_s_waitcnt(0);
        unsigned nloc = b.st[0], nx = b.st[1];
        if (nloc == 0u) { xcd_barrier_complete(bar, b.x, nloc, nx); b.st[0] = nloc; b.st[1] = nx; }
        const unsigned old = xb_add(&bar[XB_XSUB(b.x)], 1u);
        const unsigned gen = old / nloc;
        if (old + 1u == (gen + 1u) * nloc) {
            __builtin_amdgcn_fence(__ATOMIC_RELEASE, "agent");
            asm volatile("s_waitcnt vmcnt(0)" ::: "memory");
            const unsigned og = xb_add(&bar[XB_TOP], 1u);
            const unsigned tg = og / nx;
            if (og + 1u == (tg + 1u) * nx) xb_add(&bar[XB_TOPGEN], 1u);
            else XB_SPIN(xb_ld(&bar[XB_TOPGEN]) == tg, bar);
            __builtin_amdgcn_fence(__ATOMIC_ACQUIRE, "agent");
            xb_add(&bar[XB_XGEN(b.x)], 1u);
            asm volatile("s_waitcnt vmcnt(0)" ::: "memory");
        } else {
            XB_SPIN(xb_ld(&bar[XB_XGEN(b.x)]) == gen, bar);
            __builtin_amdgcn_fence(__ATOMIC_ACQUIRE, "agent");
            asm volatile("s_waitcnt vmcnt(0)" ::: "memory");
        }
    }
    __syncthreads();
}

using pg8::f32x4; using pg8::u32x4; using pg8::Unit; using pg8::cvt_pk_bf16;
typedef f32x4 acc_t[2][2][4][2];
__device__ __forceinline__ float rs_of(const float* ss, int row) { return __builtin_amdgcn_rsqf(ss[row] * (1.0f / (float)D) + EPS); }
__device__ __forceinline__ u32x4 pack8(const f32x4 a, const f32x4 b) { u32x4 w; w.x = cvt_pk_bf16(a[0], a[1]); w.y = cvt_pk_bf16(a[2], a[3]); w.z = cvt_pk_bf16(b[0], b[1]); w.w = cvt_pk_bf16(b[2], b[3]); return w; }

struct EpiSwiglu {
    static constexpr bool PERM = true;
    bf16* H; const float* ss;
    __device__ __forceinline__ void operator()(acc_t& acc, const Unit& u, int wr, int wc, int fr, int fq, int, int) const {
        const int row0 = u.pm * 256 + wr * 64 + fr, col0 = u.pn * 128 + wc * 32 + 8 * fq;
#pragma unroll
        for (int ai = 0; ai < 2; ++ai)
#pragma unroll
            for (int m = 0; m < 4; ++m) { const int row = row0 + ai * 128 + m * 16; const float r = rs_of(ss, row);
                f32x4 h[2];
#pragma unroll
                for (int n = 0; n < 2; ++n) { const f32x4 g = acc[ai][0][m][n] * r, up = acc[ai][1][m][n] * r;
#pragma unroll
                    for (int e = 0; e < 4; ++e) h[n][e] = siluf_(g[e]) * up[e]; }
                *(u32x4*)(H + (size_t)row * FF + col0) = pack8(h[0], h[1]); }
    }
};
template <bool IN_F32> struct EpiResid {
    static constexpr bool PERM = true;
    const void* xin; float* xf; bf16* xb; float* ssout; float alpha;
    __device__ __forceinline__ void operator()(acc_t& acc, const Unit& u, int wr, int wc, int fr, int fq, int, int) const {
        const int row0 = u.pm * 256 + wr * 64 + fr, col0 = u.pn * 256 + wc * 32 + 8 * fq;
#pragma unroll
        for (int ai = 0; ai < 2; ++ai)
#pragma unroll
            for (int m = 0; m < 4; ++m) { const int row = row0 + ai * 128 + m * 16; float part = 0.f;
#pragma unroll
                for (int bj = 0; bj < 2; ++bj) { const size_t off = (size_t)row * D + col0 + bj * 128;
                    f32x4 a0, a1;
                    if (IN_F32) { a0 = *(const f32x4*)((const float*)xin + off); a1 = *(const f32x4*)((const float*)xin + off + 4); }
                    else { const u32x4 w = *(const u32x4*)((const bf16*)xin + off); a0 = (f32x4){bf_lo(w.x), bf_hi(w.x), bf_lo(w.y), bf_hi(w.y)}; a1 = (f32x4){bf_lo(w.z), bf_hi(w.z), bf_lo(w.w), bf_hi(w.w)}; }
                    const f32x4 o0 = a0 + acc[ai][bj][m][0] * alpha, o1 = a1 + acc[ai][bj][m][1] * alpha;
                    if (xf) { *(f32x4*)(xf + off) = o0; *(f32x4*)(xf + off + 4) = o1; }
                    if (xb) *(u32x4*)(xb + off) = pack8(o0, o1);
                    part += (o0[0] * o0[0] + o0[1] * o0[1]) + (o0[2] * o0[2] + o0[3] * o0[3]) + (o1[0] * o1[0] + o1[1] * o1[1]) + (o1[2] * o1[2] + o1[3] * o1[3]); }
                if (ssout) { part += __shfl_xor(part, 16); part += __shfl_xor(part, 32); if (fq == 0) atomicAdd(ssout + row, part); } }
    }
};
struct EpiPlain {
    static constexpr bool PERM = true;
    bf16* O; int ldc; const float* ss; float cs;
    __device__ __forceinline__ void operator()(acc_t& acc, const Unit& u, int wr, int wc, int fr, int fq, int, int) const {
        const int row0 = u.pm * 256 + wr * 64 + fr, col0 = u.pn * 256 + wc * 32 + 8 * fq;
#pragma unroll
        for (int ai = 0; ai < 2; ++ai)
#pragma unroll
            for (int m = 0; m < 4; ++m) { const int row = row0 + ai * 128 + m * 16; const float r = (ss ? rs_of(ss, row) : 1.0f) * cs;
#pragma unroll
                for (int bj = 0; bj < 2; ++bj) *(u32x4*)(O + (size_t)row * ldc + col0 + bj * 128) = pack8(acc[ai][bj][m][0] * r, acc[ai][bj][m][1] * r); }
    }
};
struct EpiWin {
    static constexpr bool PERM = true;
    const float* ss; const float* lbraw; bf16* hq; float* logf; bf16* hi; bf16* hsg; bf16* sbq; bf16* sbk; bf16* sbv;
    __device__ __forceinline__ void operator()(acc_t& acc, const Unit& u, int wr, int wc, int fr, int fq, int, int) const {
        const int row0 = u.pm * 256 + wr * 64 + fr; const int seg = u.pn >> 1; const int cseg0 = (u.pn & 1) * 256 + wc * 32 + 8 * fq;
        if (seg == 1) {
            float lb[2][8];
#pragma unroll
            for (int bj = 0; bj < 2; ++bj)
#pragma unroll
                for (int e = 0; e < 8; ++e) { const int c = cseg0 + bj * 128 + e; lb[bj][e] = rcpf_(1.0f + ex2((lbraw[HGW + c] - lbraw[c]) * LOG2E)); }
#pragma unroll
            for (int ai = 0; ai < 2; ++ai)
#pragma unroll
                for (int m = 0; m < 4; ++m) { const int row = row0 + ai * 128 + m * 16; const float r = rs_of(ss, row);
#pragma unroll
                    for (int bj = 0; bj < 2; ++bj) { f32x4 o[2];
#pragma unroll
                        for (int n = 0; n < 2; ++n)
#pragma unroll
                            for (int e = 0; e < 4; ++e) { const float v = acc[ai][bj][m][n][e] * r; const float l = lb[bj][4 * n + e]; const float f = l + (1.0f - l) * sigmoidf_(v); o[n][e] = lg2(f) * LN2; }
                        float* p = logf + (size_t)row * HGW + cseg0 + bj * 128; *(f32x4*)p = o[0]; *(f32x4*)(p + 4) = o[1]; } }
            return;
        }
#pragma unroll
        for (int ai = 0; ai < 2; ++ai)
#pragma unroll
            for (int m = 0; m < 4; ++m) { const int row = row0 + ai * 128 + m * 16; const float r = rs_of(ss, row);
#pragma unroll
                for (int bj = 0; bj < 2; ++bj) { f32x4 v0 = acc[ai][bj][m][0] * r, v1 = acc[ai][bj][m][1] * r; const int cs = cseg0 + bj * 128;
                    bf16* dst;
                    if (seg == 0) dst = hq + (size_t)row * HGW + cs;
                    else if (seg == 2) dst = hi + (size_t)row * HGW + cs;
                    else if (seg == 3) { dst = hsg + (size_t)row * HGW + cs;
#pragma unroll
                        for (int e = 0; e < 4; ++e) { v0[e] = siluf_(v0[e]); v1[e] = siluf_(v1[e]); } }
                    else { const int b = row >> 13, s = row & (SEQ - 1), head = cs >> 6, d = cs & 63; const size_t o = ((size_t)(b * SBH + head) * SEQ + s) * SBD + d;
                        if (seg == 4) { dst = sbq + o; v0 = v0 * SB_QSCALE; v1 = v1 * SB_QSCALE; } else if (seg == 5) dst = sbk + o; else dst = sbv + o; }
                    *(u32x4*)dst = pack8(v0, v1); } }
    }
};
struct EpiSoftmax {
    static constexpr bool PERM = true;
    bf16* P; PG8_LAS unsigned char* xl;
    __device__ __forceinline__ void operator()(acc_t& acc, const Unit& u, int wr, int wc, int fr, int fq, int, int) const {
        typedef float f32x2v __attribute__((ext_vector_type(2)));
        PG8_LAS f32x2v* X = (PG8_LAS f32x2v*)xl;
        float mw[2][4];
#pragma unroll
        for (int ai = 0; ai < 2; ++ai)
#pragma unroll
            for (int m = 0; m < 4; ++m) { float mx = -3.0e38f;
#pragma unroll
                for (int bj = 0; bj < 2; ++bj)
#pragma unroll
                    for (int n = 0; n < 2; ++n) { const f32x4 v = acc[ai][bj][m][n]; mx = fmaxf(fmaxf(fmaxf(mx, v[0]), fmaxf(v[1], v[2])), v[3]); }
                mx = fmaxf(mx, __shfl_xor(mx, 16)); mx = fmaxf(mx, __shfl_xor(mx, 32));
                float s = 0.f;
#pragma unroll
                for (int bj = 0; bj < 2; ++bj)
#pragma unroll
                    for (int n = 0; n < 2; ++n) { f32x4 v = acc[ai][bj][m][n];
#pragma unroll
                        for (int e = 0; e < 4; ++e) { v[e] = ex2(v[e] - mx); s += v[e]; }
                        acc[ai][bj][m][n] = v; }
                s += __shfl_xor(s, 16); s += __shfl_xor(s, 32);
                if (fq == 0) X[(ai * 128 + wr * 64 + m * 16 + fr) * 4 + wc] = (f32x2v){mx, s};
                mw[ai][m] = mx; }
        asm volatile("s_waitcnt lgkmcnt(0)" ::: "memory"); __builtin_amdgcn_s_barrier(); asm volatile("" ::: "memory");
        const int row0 = u.pm * 256 + wr * 64 + fr, col0 = u.pn * 256 + wc * 32 + 8 * fq;
#pragma unroll
        for (int ai = 0; ai < 2; ++ai)
#pragma unroll
            for (int m = 0; m < 4; ++m) { const int rl = ai * 128 + wr * 64 + m * 16 + fr;
                const f32x2v a = X[rl * 4 + 0], b = X[rl * 4 + 1], c = X[rl * 4 + 2], d = X[rl * 4 + 3];
                const float mt = fmaxf(fmaxf(a.x, b.x), fmaxf(c.x, d.x));
                const float tot = a.y * ex2(a.x - mt) + b.y * ex2(b.x - mt) + c.y * ex2(c.x - mt) + d.y * ex2(d.x - mt);
                const float f = ex2(mw[ai][m] - mt) * rcpf_(tot);
                const int row = row0 + ai * 128 + m * 16;
#pragma unroll
                for (int bj = 0; bj < 2; ++bj) *(u32x4*)(P + (size_t)row * D + col0 + bj * 128) = pack8(acc[ai][bj][m][0] * f, acc[ai][bj][m][1] * f); }
    }
};

struct CrossOrder {
    const char* A; const char* B; int G, c, mode;
    __device__ __forceinline__ bool next(int i, Unit& u) const {
        const int L = i * G + c; if (L >= 512) return false;
        u.pm = L >> 2; u.pn = L & 3; const int b = u.pm >> 5;
        u.a = A + ((size_t)u.pm * 256 * D + u.pn * 256) * 2;
        u.b = mode == 0 ? B + ((size_t)b * 256 * D + u.pn * 256) * 2 : B + ((size_t)u.pn * 256 * D + b * 256) * 2;
        return true;
    }
};
struct OneUnit {
    const char* a; const char* b; int pm, pn;
    __device__ __forceinline__ bool next(int i, Unit& u) const { if (i > 0) return false; u.pm = pm; u.pn = pn; u.a = a; u.b = b; return true; }
};

typedef pg8::bf16x8 bf16x8;
typedef float f32x16 __attribute__((ext_vector_type(16)));
typedef short s16x4 __attribute__((ext_vector_type(4)));
typedef float f32x2_t __attribute__((ext_vector_type(2)));
typedef __bf16 bf16x2_t __attribute__((ext_vector_type(2)));
typedef unsigned u32x2 __attribute__((ext_vector_type(2)));
__device__ __forceinline__ unsigned cvtpk(float lo, float hi) { f32x2_t v = {lo, hi}; bf16x2_t b = __builtin_convertvector(v, bf16x2_t); return __builtin_bit_cast(unsigned, b); }
__device__ __forceinline__ s16x4 ldtr(LAS const unsigned char* p) { return __builtin_bit_cast(s16x4, __builtin_amdgcn_ds_read_tr16_b64_v4i16((LAS s16x4*)p)); }
__device__ __forceinline__ int crow(int r, int hi) { return (r & 3) + 8 * (r >> 2) + 4 * hi; }
#define MFMA32(a, b, c) __builtin_amdgcn_mfma_f32_32x32x16_bf16((a), (b), (c), 0, 0, 0)
__device__ __forceinline__ bf16x8 trfrag(LAS const unsigned char* tile, int pitch, int xbase, int k0, int k1, int lane) {
    const int colb = (xbase + 16 * ((lane >> 4) & 1) + 4 * (lane & 3)) * 2, rq = (lane & 15) >> 2;
    const s16x4 lo = ldtr(tile + (k0 + rq) * pitch + colb), hi = ldtr(tile + (k1 + rq) * pitch + colb);
    return (bf16x8){lo[0], lo[1], lo[2], lo[3], hi[0], hi[1], hi[2], hi[3]};
}
__device__ __forceinline__ int hsw(int row) { return ((row & 3) << 2) | ((row >> 2) & 3); }
__device__ __forceinline__ int hoff(int row, int col) { return row * 256 + ((((col >> 3) ^ hsw(row))) << 4) + (col & 7) * 2; }
__device__ __forceinline__ bf16x8 trfrag_sw(LAS const unsigned char* tile, int xbase, int k0, int k1, int lane) {
    const int col = xbase + 16 * ((lane >> 4) & 1) + 4 * (lane & 3), rq = (lane & 15) >> 2;
    const s16x4 lo = ldtr(tile + hoff(k0 + rq, col)), hi = ldtr(tile + hoff(k1 + rq, col));
    return (bf16x8){lo[0], lo[1], lo[2], lo[3], hi[0], hi[1], hi[2], hi[3]};
}
template <int S8> __device__ __forceinline__ bf16x8 acc_frag(const f32x16& v) {
    pg8::u32x4 w; w.x = cvtpk(v[8 * S8 + 0], v[8 * S8 + 1]); w.y = cvtpk(v[8 * S8 + 2], v[8 * S8 + 3]); w.z = cvtpk(v[8 * S8 + 4], v[8 * S8 + 5]); w.w = cvtpk(v[8 * S8 + 6], v[8 * S8 + 7]);
    return __builtin_bit_cast(bf16x8, w);
}
template <int S8> __device__ __forceinline__ void acc_frag_hl(const f32x16& v, bf16x8& H, bf16x8& L) {
    pg8::u32x4 hw, lw;
#pragma unroll
    for (int p = 0; p < 4; ++p) { const float a = v[8 * S8 + 2 * p], b = v[8 * S8 + 2 * p + 1]; const unsigned hp = cvtpk(a, b); hw[p] = hp; lw[p] = cvtpk(a - bf_lo(hp), b - bf_hi(hp)); }
    H = __builtin_bit_cast(bf16x8, hw); L = __builtin_bit_cast(bf16x8, lw);
}
__device__ __forceinline__ float softplus2(float z) { return fmaxf(z, 0.f) + lg2(1.0f + ex2(-fabsf(z))); }

__device__ __forceinline__ void sb_qblock(const bf16* SBQ, const bf16* SBK, const bf16* SBV, const float* gsb, bf16* MIXED, int bh, int qi, LAS unsigned char* vl, int lane) {
    const int r32 = lane & 31, hi = lane >> 5, q0 = qi * 32, b = bh >> 3, h = bh & 7;
    const bf16* Qb = SBQ + ((size_t)bh * SEQ + q0) * SBD;
    const bf16* Kh = SBK + (size_t)bh * SEQ * SBD; const bf16* Vh = SBV + (size_t)bh * SEQ * SBD;
    bf16x8 qf[4], kf[4];
#pragma unroll
    for (int ks = 0; ks < 4; ++ks) { qf[ks] = *(const bf16x8*)(Qb + r32 * SBD + ks * 16 + hi * 8); kf[ks] = *(const bf16x8*)(Kh + (size_t)(q0 + r32) * SBD + ks * 16 + hi * 8); }
    bf16x8 tri[2];
#pragma unroll
    for (int s8 = 0; s8 < 2; ++s8)
#pragma unroll
        for (int j = 0; j < 8; ++j) { const int jk = 16 * s8 + 8 * (j >> 2) + 4 * hi + (j & 3); tri[s8][j] = jk >= r32 ? (short)0x3F80 : (short)0; }
    f32x16 ot0 = {}, ot1 = {}; float carry = 0.f;
    for (int kb = qi; kb >= 0; --kb) {
        const bf16* Vt = Vh + (size_t)kb * 32 * SBD;
        v4u vv[4];
#pragma unroll
        for (int i = 0; i < 4; ++i) vv[i] = *(const v4u*)(Vt + (i * 64 + lane) * 8);
        f32x16 st = {};
#pragma unroll
        for (int ks = 0; ks < 4; ++ks) st = MFMA32(kf[ks], qf[ks], st);
        if (kb > 0) {
#pragma unroll
            for (int ks = 0; ks < 4; ++ks) kf[ks] = *(const bf16x8*)(Kh + (size_t)((kb - 1) * 32 + r32) * SBD + ks * 16 + hi * 8);
        }
        const int qlim = kb == qi ? r32 - 4 * hi : 4096;
        f32x16 sp;
#pragma unroll
        for (int r = 0; r < 16; ++r) sp[r] = ((r & 3) + 8 * (r >> 2)) < qlim ? softplus2(st[r]) : 0.f;
        bf16x8 H0, H1, L0, L1;
        acc_frag_hl<0>(sp, H0, L0); acc_frag_hl<1>(sp, H1, L1);
        f32x16 c;
#pragma unroll
        for (int r = 0; r < 16; ++r) c[r] = carry;
        c = MFMA32(tri[0], H0, c); c = MFMA32(tri[1], H1, c); c = MFMA32(tri[0], L0, c); c = MFMA32(tri[1], L1, c);
        f32x16 w;
#pragma unroll
        for (int r = 0; r < 16; ++r) w[r] = ((r & 3) + 8 * (r >> 2)) < qlim ? ex2(st[r] - c[r]) : 0.f;
        carry = __shfl(c[0], r32);
        const bf16x8 p0 = acc_frag<0>(w), p1 = acc_frag<1>(w);
        asm volatile("" ::: "memory");
#pragma unroll
        for (int i = 0; i < 4; ++i) *(LAS v4u*)(vl + (i * 64 + lane) * 16) = vv[i];
        asm volatile("" ::: "memory");
        ot0 = MFMA32(trfrag(vl, 128, 0, 4 * hi, 8 + 4 * hi, lane), p0, ot0);        ot1 = MFMA32(trfrag(vl, 128, 32, 4 * hi, 8 + 4 * hi, lane), p0, ot1);
        ot0 = MFMA32(trfrag(vl, 128, 0, 16 + 4 * hi, 24 + 4 * hi, lane), p1, ot0);  ot1 = MFMA32(trfrag(vl, 128, 32, 16 + 4 * hi, 24 + 4 * hi, lane), p1, ot1);
        asm volatile("" ::: "memory");
        if (__all(carry > SB_STOP)) break;
    }
    float ssq = 0.f;
#pragma unroll
    for (int r = 0; r < 16; ++r) ssq += ot0[r] * ot0[r] + ot1[r] * ot1[r];
    ssq += __shfl_xor(ssq, 32);
    const float rstd = __builtin_amdgcn_rsqf(ssq * (1.0f / (float)SBD) + EPS);
    bf16* orow = MIXED + ((size_t)b * SEQ + q0 + r32) * D + HGW + h * SBD;
#pragma unroll
    for (int rg = 0; rg < 4; ++rg) { const int d0 = 8 * rg + 4 * hi;
        const f32x4 g0 = *(const f32x4*)(gsb + h * SBD + d0), g1 = *(const f32x4*)(gsb + h * SBD + 32 + d0);
        u32x2 a, c2; a.x = cvtpk(ot0[4 * rg] * rstd * g0[0], ot0[4 * rg + 1] * rstd * g0[1]); a.y = cvtpk(ot0[4 * rg + 2] * rstd * g0[2], ot0[4 * rg + 3] * rstd * g0[3]);
        c2.x = cvtpk(ot1[4 * rg] * rstd * g1[0], ot1[4 * rg + 1] * rstd * g1[1]); c2.y = cvtpk(ot1[4 * rg + 2] * rstd * g1[2], ot1[4 * rg + 3] * rstd * g1[3]);
        *(u32x2*)(orow + d0) = a; *(u32x2*)(orow + 32 + d0) = c2; }
}

constexpr int HG_T0 = 0, HG_T1 = 16384, HG_T2 = 32768, HG_T3 = 49152, HG_TOT = 65536, HG_SSQ = HG_TOT + 2048;
__device__ __forceinline__ void hg_front(const float* LOGF, const bf16* HI, size_t rbase, int h, LAS unsigned char* lds, int tid, float (&lf)[16], float (&bb)[16], float& all, float& mid) {
    const int ch = tid & 127, tg = tid >> 7;
    v4u vt[2];
#pragma unroll
    for (int i = 0; i < 2; ++i) { const int chunk = tid + 512 * i, row = chunk >> 4, cc = chunk & 15; vt[i] = *(const v4u*)(HI + (rbase + row) * HGW + h * HGD + cc * 8); }
#pragma unroll
    for (int k = 0; k < 16; ++k) { lf[k] = LOGF[(rbase + tg * 16 + k) * HGW + h * HGD + ch]; }
    float run = 0.f;
#pragma unroll
    for (int k = 0; k < 16; ++k) { run += lf[k]; bb[k] = run; }
    LAS float* TOT = (LAS float*)(lds + HG_TOT);
    TOT[tg * 128 + ch] = run;
#pragma unroll
    for (int i = 0; i < 2; ++i) { const int chunk = tid + 512 * i, row = chunk >> 4, cc = chunk & 15; *(LAS v4u*)(lds + HG_T3 + hoff(row, cc * 8)) = vt[i]; }
    __syncthreads();
    const float t0 = TOT[ch], t1 = TOT[128 + ch], t2 = TOT[256 + ch], t3 = TOT[384 + ch];
    const float pre = tg == 0 ? 0.f : tg == 1 ? t0 : tg == 2 ? t0 + t1 : t0 + t1 + t2;
    all = (t0 + t1) + (t2 + t3); mid = t0 + t1;
#pragma unroll
    for (int k = 0; k < 16; ++k) bb[k] += pre;
}
__device__ __forceinline__ void hg_pass1(const float* LOGF, const bf16* HI, bf16* ST, float* DVEC, int item, LAS unsigned char* lds, int tid, int wave, int lane) {
    const int c = item & 127, bh = item >> 7, b = bh >> 2, h = bh & 3; const size_t rbase = (size_t)b * SEQ + c * 64;
    const int ch = tid & 127, tg = tid >> 7, r32 = lane & 31, hi = lane >> 5;
    float lf[16], bb[16], all, mid;
    hg_front(LOGF, HI, rbase, h, lds, tid, lf, bb, all, mid);
#pragma unroll
    for (int k = 0; k < 16; ++k) { const float f = ex2(lf[k] * LOG2E); const float kd = (1.0f - f) * ex2((all - bb[k]) * LOG2E);
        *(LAS bf16*)(lds + HG_T0 + hoff(tg * 16 + k, ch)) = (bf16)f2bf(kd); }
    if (tg == 0) DVEC[(size_t)item * HGD + ch] = ex2(all * LOG2E);
    __syncthreads();
    const int dkb = wave >> 1;
#pragma unroll
    for (int tl = 0; tl < 2; ++tl) { const int dvb = 2 * (wave & 1) + tl; f32x16 acc = {};
#pragma unroll
        for (int ks = 0; ks < 4; ++ks) { const int k0 = 16 * ks + 8 * hi;
            acc = MFMA32(trfrag_sw(lds + HG_T0, 32 * dkb, k0, k0 + 4, lane), trfrag_sw(lds + HG_T3, 32 * dvb, k0, k0 + 4, lane), acc); }
        bf16* dst = ST + ((size_t)item * HGD + 32 * dvb + r32) * HGD + 32 * dkb;
#pragma unroll
        for (int rg = 0; rg < 4; ++rg) { u32x2 w; w.x = cvtpk(acc[4 * rg], acc[4 * rg + 1]); w.y = cvtpk(acc[4 * rg + 2], acc[4 * rg + 3]); *(u32x2*)(dst + 8 * rg + 4 * hi) = w; } }
    __syncthreads();
}
__device__ __forceinline__ void hg_pass3(const float* LOGF, const bf16* HQ, const bf16* HI, const bf16* HSG, const bf16* ST, const float* ghg, bf16* MIXED, int item, LAS unsigned char* lds, int tid, int wave, int lane) {
    const int c = item & 127, bh = item >> 7, b = bh >> 2, h = bh & 3; const size_t rbase = (size_t)b * SEQ + c * 64;
    const int ch = tid & 127, tg = tid >> 7, r32 = lane & 31, hi = lane >> 5;
    const int dvb = wave >> 1, tb = wave & 1, tl = 32 * tb + r32; const size_t row = rbase + tl;
    bf16x8 sf[8];
#pragma unroll
    for (int ks = 0; ks < 8; ++ks) sf[ks] = *(const bf16x8*)(ST + ((size_t)item * HGD + 32 * dvb + r32) * HGD + 16 * ks + 8 * hi);
    bf16 qraw[16];
#pragma unroll
    for (int k = 0; k < 16; ++k) qraw[k] = HQ[(rbase + tg * 16 + k) * HGW + h * HGD + ch];
    u32x2 sgv[4]; f32x4 gv[4];
#pragma unroll
    for (int rg = 0; rg < 4; ++rg) { const int col = h * HGD + 32 * dvb + 8 * rg + 4 * hi; sgv[rg] = *(const u32x2*)(HSG + row * HGW + col); gv[rg] = *(const f32x4*)(ghg + col); }
    float lf[16], bb[16], all, mid;
    hg_front(LOGF, HI, rbase, h, lds, tid, lf, bb, all, mid);
#pragma unroll
    for (int k = 0; k < 16; ++k) { const int t = tg * 16 + k; const float q = bf2f(qraw[k]);
        const float f = ex2(lf[k] * LOG2E); const float e1 = fminf(fmaxf(bb[k] - mid, -80.f), 80.f) * LOG2E;
        *(LAS bf16*)(lds + HG_T0 + hoff(t, ch)) = (bf16)f2bf(q * ex2(bb[k] * LOG2E));
        *(LAS bf16*)(lds + HG_T1 + hoff(t, ch)) = (bf16)f2bf(q * ex2(e1));
        *(LAS bf16*)(lds + HG_T2 + hoff(t, ch)) = (bf16)f2bf((1.0f - f) * ex2(-e1)); }
    __syncthreads();
    f32x16 ot = {};
#pragma unroll
    for (int ks = 0; ks < 8; ++ks)
        ot = MFMA32(sf[ks], *(const LAS bf16x8*)(lds + HG_T0 + hoff(32 * tb + r32, 16 * ks + 8 * hi)), ot);
#pragma unroll
    for (int sb = 0; sb < 2; ++sb) {
        if (sb <= tb) {
            f32x16 at = {};
#pragma unroll
            for (int ks = 0; ks < 8; ++ks)
                at = MFMA32(*(const LAS bf16x8*)(lds + HG_T2 + hoff(32 * sb + r32, 16 * ks + 8 * hi)), *(const LAS bf16x8*)(lds + HG_T1 + hoff(32 * tb + r32, 16 * ks + 8 * hi)), at);
            if (sb == tb) {
#pragma unroll
                for (int r = 0; r < 16; ++r) at[r] = ((r & 3) + 8 * (r >> 2)) <= r32 - 4 * hi ? at[r] : 0.f;
            }
            const bf16x8 p0 = acc_frag<0>(at), p1 = acc_frag<1>(at);
            ot = MFMA32(trfrag_sw(lds + HG_T3, 32 * dvb, 32 * sb + 4 * hi, 32 * sb + 8 + 4 * hi, lane), p0, ot);
            ot = MFMA32(trfrag_sw(lds + HG_T3, 32 * dvb, 32 * sb + 16 + 4 * hi, 32 * sb + 24 + 4 * hi, lane), p1, ot);
        }
    }
    float ssq = 0.f;
#pragma unroll
    for (int r = 0; r < 16; ++r) ssq += ot[r] * ot[r];
    ssq += __shfl_xor(ssq, 32);
    LAS float* SSQ = (LAS float*)(lds + HG_SSQ);
    if (hi == 0) SSQ[dvb * 64 + tl] = ssq;
    __syncthreads();
    const float rstd = __builtin_amdgcn_rsqf(((SSQ[tl] + SSQ[64 + tl]) + (SSQ[128 + tl] + SSQ[192 + tl])) * (1.0f / (float)HGD) + EPS);
#pragma unroll
    for (int rg = 0; rg < 4; ++rg) { const int col = h * HGD + 32 * dvb + 8 * rg + 4 * hi; const f32x4 g = gv[rg]; const u32x2 sg = sgv[rg];
        u32x2 w; w.x = cvtpk(ot[4 * rg] * rstd * g[0] * bf_lo(sg.x), ot[4 * rg + 1] * rstd * g[1] * bf_hi(sg.x)); w.y = cvtpk(ot[4 * rg + 2] * rstd * g[2] * bf_lo(sg.y), ot[4 * rg + 3] * rstd * g[3] * bf_hi(sg.y));
        *(u32x2*)(MIXED + row * D + col) = w; }
    __syncthreads();
}

struct Args { const float* in[20]; float* out; unsigned char* ws; int ph_lo, ph_hi; };

__device__ __forceinline__ void transpose_item(const float* W, int K, int N, bf16* WT, const float* gain, int mode, LAS float* scr, int item, int lane) {
    const int nblk = N / 32, kb = item / nblk, nb = item % nblk, k0 = 64 * kb, n0 = 32 * nb;
    float wv[32];
#pragma unroll
    for (int i = 0; i < 32; ++i) wv[i] = W[(size_t)(k0 + 2 * i + (lane >> 5)) * N + n0 + (lane & 31)];
    if (gain) {
#pragma unroll
        for (int i = 0; i < 32; ++i) wv[i] *= gain[k0 + 2 * i + (lane >> 5)];
    }
#pragma unroll
    for (int i = 0; i < 32; ++i) scr[(2 * i + (lane >> 5)) * 33 + (lane & 31)] = wv[i];
    LDS_WAIT(); asm volatile("" ::: "memory");
    int orow0 = n0;
    if (mode == 1) { const int j = n0 < FF ? n0 : n0 - FF; orow0 = (j >> 7) * 256 + (n0 < FF ? 0 : 128) + (j & 127); }
    const int c = lane & 7;
#pragma unroll
    for (int j = 0; j < 4; ++j) { const int n = (lane >> 3) + 8 * j; const LAS float* s = scr + (8 * c) * 33 + n;
        v4u o; o.x = pk2(s[0 * 33], s[1 * 33]); o.y = pk2(s[2 * 33], s[3 * 33]); o.z = pk2(s[4 * 33], s[5 * 33]); o.w = pk2(s[6 * 33], s[7 * 33]);
        *(GAS v4u*)(WT + (size_t)(orow0 + n) * K + k0 + 8 * c) = o; }
    LDS_WAIT(); asm volatile("" ::: "memory");
}

__global__ void __launch_bounds__(NWAVES * 64, 2) layer_fwd(Args args) {
    extern __shared__ __attribute__((aligned(16))) unsigned char lds_raw[];
    LAS unsigned char* lds = (LAS unsigned char*)lds_raw;
    volatile LAS unsigned* MISC = (volatile LAS unsigned*)(lds + MISC_OFF);
    const int tid = threadIdx.x, lane = tid & 63, wave = __builtin_amdgcn_readfirstlane(tid >> 6);
    const int G = gridDim.x, bx = blockIdx.x;
    const int vcu = (G % 8 == 0) ? (bx % 8) * (G / 8) + bx / 8 : bx;
    unsigned char* ws = args.ws;
    gu32* ctl = (gu32*)(ws + WS_CTL);
    float* ss0 = (float*)(ws + WS_SS); float* ss1 = ss0 + M; float* ss2 = ss1 + M; float* ss3 = ss2 + M;
    bf16* Wgu1 = (bf16*)(ws + WS_WGU1); bf16* Wd1 = (bf16*)(ws + WS_WD1); bf16* Win = (bf16*)(ws + WS_WIN); bf16* Wout = (bf16*)(ws + WS_WOUT);
    bf16* Wq = (bf16*)(ws + WS_WQ); bf16* Wkv = (bf16*)(ws + WS_WKV); bf16* Wo = (bf16*)(ws + WS_WO); bf16* Wgu2 = (bf16*)(ws + WS_WGU2); bf16* Wd2 = (bf16*)(ws + WS_WD2);
    bf16* MN = (bf16*)(ws + WS_MN); bf16* KMEM = (bf16*)(ws + WS_KMEM); bf16* VT = (bf16*)(ws + WS_VT);
    bf16* XB = (bf16*)(ws + WS_XB); bf16* HMID = (bf16*)(ws + WS_HMID);
    bf16* HQ = (bf16*)(ws + WS_HQ); float* LOGF = (float*)(ws + WS_LOGF); bf16* HI = (bf16*)(ws + WS_HI); bf16* HSG = (bf16*)(ws + WS_HSG);
    bf16* SBQ = (bf16*)(ws + WS_SBQ); bf16* SBK = (bf16*)(ws + WS_SBK); bf16* SBV = (bf16*)(ws + WS_SBV);
    bf16* MIXED = (bf16*)(ws + WS_MIXED); bf16* STb = (bf16*)args.out;     float* DVEC = (float*)(ws + WS_DVEC); bf16* QC = (bf16*)(ws + WS_QC); bf16* PMb = (bf16*)(ws + WS_PM); bf16* OC = (bf16*)(ws + WS_OC);
    const float* x_in = args.in[0]; float* out = args.out;

    for (int u = tid; u < (LDS_BYTES - LDSCTL_OFF) / 4; u += NWAVES * 64) ((LAS unsigned*)(lds + LDSCTL_OFF))[u] = 0u;
    __syncthreads();
#if MK_ONE_LAUNCH
    XcdBarrier bar = xcd_barrier_post((unsigned*)(ctl + CW_BAR), MISC + 8);
#define GRID_BAR() xcd_barrier(bar)
#else
#define GRID_BAR() do { } while (0)
#endif
    const int lo = args.ph_lo, hi = args.ph_hi;
#define IN(k) (lo <= (k) && (k) < hi)
#ifdef PROBE_PHASE
    unsigned long long* stampw = (unsigned long long*)(ws + WS_CTL + 65536);
#define STAMP(k) do { if (bx == 0 && tid == 0) stampw[(k) + 1] = __builtin_amdgcn_s_memrealtime(); } while (0)
    if (bx == 0 && tid == 0) stampw[0] = __builtin_amdgcn_s_memrealtime();
#else
#define STAMP(k) do { } while (0)
#endif
#define SEAM(k) do { if (IN(k) && IN((k) + 1)) GRID_BAR(); STAMP(k); } while (0)
    const int gw = vcu * NWAVES + wave, NGW = G * NWAVES;

    if (IN(0)) {
        LAS float* scr = (LAS float*)(lds + wave * 16384);
        constexpr int I_GU = (D / 64) * (GU / 32), I_DN = (FF / 64) * (D / 32), I_IN = (D / 64) * (INC / 32), I_SQ = (D / 64) * (D / 32), I_KV = (D / 64) * (2 * D / 32);
        constexpr int NITEMS = 2 * I_GU + 2 * I_DN + I_IN + 3 * I_SQ + I_KV;
        for (int it = gw; it < NITEMS; it += NGW) {
            int r = it;
            if (r < I_GU) { transpose_item(args.in[3], D, GU, Wgu1, args.in[2], 1, scr, r, lane); continue; } r -= I_GU;
            if (r < I_GU) { transpose_item(args.in[17], D, GU, Wgu2, args.in[16], 1, scr, r, lane); continue; } r -= I_GU;
            if (r < I_DN) { transpose_item(args.in[4], FF, D, Wd1, nullptr, 0, scr, r, lane); continue; } r -= I_DN;
            if (r < I_DN) { transpose_item(args.in[18], FF, D, Wd2, nullptr, 0, scr, r, lane); continue; } r -= I_DN;
            if (r < I_IN) { transpose_item(args.in[6], D, INC, Win, args.in[5], 0, scr, r, lane); continue; } r -= I_IN;
            if (r < I_SQ) { transpose_item(args.in[10], D, D, Wout, nullptr, 0, scr, r, lane); continue; } r -= I_SQ;
            if (r < I_SQ) { transpose_item(args.in[13], D, D, Wq, args.in[11], 0, scr, r, lane); continue; } r -= I_SQ;
            if (r < I_SQ) { transpose_item(args.in[15], D, D, Wo, nullptr, 0, scr, r, lane); continue; } r -= I_SQ;
            transpose_item(args.in[14], D, 2 * D, Wkv, nullptr, 0, scr, r, lane);
        }
        for (int m = gw; m < M; m += 2 * NGW) {
            const GAS f32x4* xr0 = (const GAS f32x4*)(x_in + (size_t)m * D) + lane; const GAS f32x4* xr1 = (const GAS f32x4*)(x_in + (size_t)(m + NGW) * D) + lane; f32x4 v[4], w[4]; float s = 0.f, s1 = 0.f;
#pragma unroll
            for (int j = 0; j < 4; ++j) { v[j] = xr0[64 * j]; w[j] = xr1[64 * j]; }
#pragma unroll
            for (int j = 0; j < 4; ++j) { s += (v[j].x * v[j].x + v[j].y * v[j].y) + (v[j].z * v[j].z + v[j].w * v[j].w); s1 += (w[j].x * w[j].x + w[j].y * w[j].y) + (w[j].z * w[j].z + w[j].w * w[j].w); }
            GAS unsigned long long* o8 = (GAS unsigned long long*)(XB + (size_t)m * D) + lane; GAS unsigned long long* p8 = (GAS unsigned long long*)(XB + (size_t)(m + NGW) * D) + lane;
#pragma unroll
            for (int j = 0; j < 4; ++j) { o8[64 * j] = (unsigned long long)pk2(v[j].x, v[j].y) | ((unsigned long long)pk2(v[j].z, v[j].w) << 32); p8[64 * j] = (unsigned long long)pk2(w[j].x, w[j].y) | ((unsigned long long)pk2(w[j].z, w[j].w) << 32); }
            s = wave_sum(s); s1 = wave_sum(s1);
            if (lane == 0) { ss0[m] = s; ss0[m + NGW] = s1; }
        }
        for (int m = gw; m < MROWS; m += NGW) {
            const GAS f32x4* xr = (const GAS f32x4*)(args.in[1] + (size_t)m * D) + lane; const GAS f32x4* gr = (const GAS f32x4*)(args.in[12]) + lane; f32x4 v[4]; float s = 0.f;
#pragma unroll
            for (int j = 0; j < 4; ++j) { v[j] = xr[64 * j]; s += (v[j].x * v[j].x + v[j].y * v[j].y) + (v[j].z * v[j].z + v[j].w * v[j].w); }
            const float r = __builtin_amdgcn_rsqf(wave_sum(s) * (1.0f / (float)D) + EPS);
            GAS unsigned long long* o8 = (GAS unsigned long long*)(MN + (size_t)m * D) + lane;
#pragma unroll
            for (int j = 0; j < 4; ++j) { const f32x4 g = gr[64 * j]; o8[64 * j] = (unsigned long long)pk2(v[j].x * r * g.x, v[j].y * r * g.y) | ((unsigned long long)pk2(v[j].z * r * g.z, v[j].w * r * g.w) << 32); }
        }
    }
    SEAM(0);
    if (IN(1)) { pg8::TileOrder S; S.init(XB, Wgu1, D, D, M, GU, G, bx); EpiSwiglu E{HMID, ss0}; pg8::gemm_phase(lds, D, D, D, S, E); }
    SEAM(1);
    if (IN(2)) { pg8::TileOrder S; S.init(HMID, Wd1, FF, FF, M, D, G, bx); EpiResid<true> E{x_in, nullptr, XB, ss1, 0.5f}; pg8::gemm_phase(lds, FF, FF, FF, S, E); }
    SEAM(2);
    if (IN(3)) { pg8::TileOrder S; S.init(XB, Win, D, D, M, INC, G, bx); EpiWin E{ss1, args.in[7], HQ, LOGF, HI, HSG, SBQ, SBK, SBV}; pg8::gemm_phase(lds, D, D, D, S, E); }
    SEAM(3);
    if (IN(4)) {
        for (int it = bx; it < BATCH * HGH * (SEQ / 64); it += G) hg_pass1(LOGF, HI, STb, DVEC, it, lds, tid, wave, lane);
        for (int T = bx; T < BATCH * SBH * (SEQ / 256); T += G)
            sb_qblock(SBQ, SBK, SBV, args.in[9], MIXED, T >> 5, (T & 31) * 8 + wave, lds + wave * 4096, lane);
    }
    SEAM(4);
    if (IN(5)) {
        if (bx < 16) {
            const int L = bx; OneUnit S{(const char*)(MN + (size_t)(L >> 2) * 256 * D), (const char*)(Wkv + (size_t)(L & 3) * 256 * D), L >> 2, L & 3};
            EpiPlain E{KMEM, D, nullptr, 1.0f}; pg8::gemm_phase(lds, D, D, D, S, E);
        } else if (bx < 32) {
            const int L = bx - 16; OneUnit S{(const char*)(Wkv + (size_t)(D + (L >> 2) * 256) * D), (const char*)(MN + (size_t)(L & 3) * 256 * D), L >> 2, L & 3};
            EpiPlain E{VT, D, nullptr, 1.0f}; pg8::gemm_phase(lds, D, D, D, S, E);
        } else {
            const int gid = (bx - 32) * 512 + tid;
            if (gid < BATCH * HGH * HGD * HGD / 4) {
                const int bh = gid >> 12, e = (gid & 4095) * 4, dk = e & 127;
                bf16* sp = STb + (size_t)bh * 128 * (HGD * HGD) + e; const float* dp = DVEC + (size_t)bh * 128 * HGD + dk;
                f32x4 Sv = {0.f, 0.f, 0.f, 0.f};
                for (int c0 = 0; c0 < 128; c0 += 8) {
                    u32x2 u[8]; f32x4 dd[8];
#pragma unroll
                    for (int j = 0; j < 8; ++j) { u[j] = *(const u32x2*)(sp + (size_t)(c0 + j) * (HGD * HGD)); dd[j] = *(const f32x4*)(dp + (size_t)(c0 + j) * HGD); }
#pragma unroll
                    for (int j = 0; j < 8; ++j) { u32x2 o; o.x = cvtpk(Sv[0], Sv[1]); o.y = cvtpk(Sv[2], Sv[3]); *(u32x2*)(sp + (size_t)(c0 + j) * (HGD * HGD)) = o;
                        Sv[0] = dd[j][0] * Sv[0] + bf_lo(u[j].x); Sv[1] = dd[j][1] * Sv[1] + bf_hi(u[j].x); Sv[2] = dd[j][2] * Sv[2] + bf_lo(u[j].y); Sv[3] = dd[j][3] * Sv[3] + bf_hi(u[j].y); }
                }
            }
        }
    }
    SEAM(5);
    if (IN(6)) { for (int it = bx; it < BATCH * HGH * (SEQ / 64); it += G) hg_pass3(LOGF, HQ, HI, HSG, STb, args.in[8], MIXED, it, lds, tid, wave, lane); }
    SEAM(6);
    if (IN(7)) { pg8::TileOrder S; S.init(MIXED, Wout, D, D, M, D, G, bx); EpiResid<false> E{XB, nullptr, XB, ss2, 1.0f}; pg8::gemm_phase(lds, D, D, D, S, E); }
    SEAM(7);
    if (IN(8)) { pg8::TileOrder S; S.init(XB, Wq, D, D, M, D, G, bx); EpiPlain E{QC, D, ss2, CA_QSCALE}; pg8::gemm_phase(lds, D, D, D, S, E); }
    SEAM(8);
    if (IN(9)) { CrossOrder S{(const char*)QC, (const char*)KMEM, G, bx, 0}; EpiSoftmax E{PMb, lds + EPI_OFF}; int kc = CHD; asm volatile("" : "+s"(kc)); pg8::gemm_phase(lds, kc, D, D, S, E); }
    SEAM(9);
    if (IN(10)) { CrossOrder S{(const char*)PMb, (const char*)VT, G, bx, 1}; EpiPlain E{OC, D, nullptr, 1.0f}; int kc = NMEM; asm volatile("" : "+s"(kc)); pg8::gemm_phase(lds, kc, D, D, S, E); }
    SEAM(10);
    if (IN(11)) { pg8::TileOrder S; S.init(OC, Wo, D, D, M, D, G, bx); EpiResid<false> E{XB, nullptr, XB, ss3, 1.0f}; pg8::gemm_phase(lds, D, D, D, S, E); }
    SEAM(11);
    if (IN(12)) { pg8::TileOrder S; S.init(XB, Wgu2, D, D, M, GU, G, bx); EpiSwiglu E{HMID, ss3}; pg8::gemm_phase(lds, D, D, D, S, E); }
    SEAM(12);
    if (IN(13)) { pg8::TileOrder S; S.init(HMID, Wd2, FF, FF, M, D, G, bx); EpiResid<false> E{XB, out, nullptr, nullptr, 0.5f}; pg8::gemm_phase(lds, FF, FF, FF, S, E); }
    SEAM(13);
    if (IN(14)) {
        const GAS f32x4* gr = (const GAS f32x4*)(args.in[19]) + lane;
        for (int m = gw; m < M; m += NGW) {
            GAS f32x4* xr = (GAS f32x4*)(out + (size_t)m * D) + lane; f32x4 v[4]; float s = 0.f;
#pragma unroll
            for (int j = 0; j < 4; ++j) { v[j] = xr[64 * j]; s += (v[j].x * v[j].x + v[j].y * v[j].y) + (v[j].z * v[j].z + v[j].w * v[j].w); }
            const float r = __builtin_amdgcn_rsqf(wave_sum(s) * (1.0f / (float)D) + EPS);
#pragma unroll
            for (int j = 0; j < 4; ++j) { const f32x4 g = gr[64 * j]; xr[64 * j] = v[j] * r * g; }
        }
    }
#ifdef PROBE_PHASE
    if (bx == 0) { VM_WAIT(); __syncthreads(); if (tid == 0) { stampw[15] = __builtin_amdgcn_s_memrealtime();
        const unsigned long long dt = (PROBE_PHASE >= 90) ? stampw[15] - stampw[0] : stampw[PROBE_PHASE + 1] - stampw[PROBE_PHASE];
        out[0] += (float)dt * 0.01f * (PROBE_PHASE >= 90 ? 0.002f : 0.01f); } }
#endif
#undef IN
#undef SEAM
}

constexpr int N_PHASES = 15;
extern "C" void kernel_launch(void* const* d_in, const int* in_sizes, int n_in, void* d_out, int out_size, void* d_ws, size_t ws_size, hipStream_t stream) {
    static int grid = 0;
    if (grid == 0) {
        if (n_in != 20 || in_sizes[0] != M * D || out_size != M * D || ws_size < WS_END) { fprintf(stderr, "kernel_launch: unexpected shapes (n_in %d, in0 %d, out %d, ws %zu)\n", n_in, n_in > 0 ? in_sizes[0] : -1, out_size, ws_size); grid = -1; return; }
        int dev = 0, cus = 0;
        if (hipGetDevice(&dev) != hipSuccess || hipDeviceGetAttribute(&cus, hipDeviceAttributeMultiprocessorCount, dev) != hipSuccess) { grid = -1; return; }
        if (hipFuncSetAttribute((const void*)layer_fwd, hipFuncAttributeMaxDynamicSharedMemorySize, LDS_BYTES) != hipSuccess) { fprintf(stderr, "kernel_launch: hipFuncSetAttribute failed\n"); grid = -1; return; }
        int per_cu = 0;
        if (hipOccupancyMaxActiveBlocksPerMultiprocessor(&per_cu, (const void*)layer_fwd, NWAVES * 64, LDS_BYTES) != hipSuccess || per_cu < 1) fprintf(stderr, "kernel_launch: occupancy query says %d\n", per_cu);
        (void)hipGetLastError();
        grid = cus;
    }
    if (grid < 0) return;
    if (hipMemsetAsync((char*)d_ws + WS_CTL, 0, CTL_ZERO_BYTES, stream) != hipSuccess) return;
    Args a{};
    for (int i = 0; i < 20; ++i) a.in[i] = (const float*)d_in[i];
    a.out = (float*)d_out; a.ws = (unsigned char*)d_ws;
#if MK_ONE_LAUNCH
    a.ph_lo = 0; a.ph_hi = N_PHASES;
    hipLaunchKernelGGL(layer_fwd, dim3(grid), dim3(NWAVES * 64), LDS_BYTES, stream, a);
#else
    for (int p = 0; p < N_PHASES; ++p) { a.ph_lo = p; a.ph_hi = p + 1; hipLaunchKernelGGL(layer_fwd, dim3(grid), dim3(NWAVES * 64), LDS_BYTES, stream, a); }
#endif
}
```

```cpp
#include <hip/hip_runtime.h>
#include <cstdio>
#include <cstdint>

#ifndef MK_ONE_LAUNCH
#define MK_ONE_LAUNCH 1
#endif

namespace pg8 {
#define PG8_LAS __attribute__((address_space(3)))
typedef unsigned short bf16_t;
typedef short bf16x8 __attribute__((ext_vector_type(8)));
typedef float f32x4 __attribute__((ext_vector_type(4)));
typedef float f32x2 __attribute__((ext_vector_type(2)));
typedef unsigned u32x4 __attribute__((ext_vector_type(4)));
constexpr int BM = 256, BK = 64, HALF = 128, HTB = HALF * BK * 2, STAGE_BYTES = 8 * HTB, NXCD = 8, WGM = 8;

__host__ __device__ __forceinline__ int lds_byte(int r, int c) { const int st = (r >> 4) * 2 + (c >> 5), rr = r & 15, cc = c & 31, ob = rr * 64 + cc * 2; return st * 1024 + (ob ^ (((ob >> 9) & 1) << 5)); }
__host__ __device__ __forceinline__ void stage_rc(int b, int& R, int& C) { const int st = b / 1024, sb = b % 1024, swz = sb ^ (((sb >> 9) & 1) << 5); R = (st >> 1) * 16 + swz / 64; C = (st & 1) * 32 + (swz % 64) / 2; }
__host__ __device__ __forceinline__ int perm32(int rho) { const int n = rho >> 4, i = rho & 15; return 8 * (i >> 2) + 4 * n + (i & 3); }

struct Unit { int pm, pn, z; const char* a; const char* b; };

__device__ __forceinline__ unsigned cvt_pk_bf16(float lo, float hi) { unsigned r; asm volatile("v_cvt_pk_bf16_f32 %0, %1, %2" : "=v"(r) : "v"(lo), "v"(hi)); return r; }

struct TileOrder {
    const char* A; const char* B; int lda, ldb; int nM, nN, nwg, G, c;
    __device__ __forceinline__ void init(const void* A_, const void* B_, int lda_, int ldb_, int M, int N, int G_, int c_) { A = (const char*)A_; B = (const char*)B_; lda = lda_; ldb = ldb_; nM = M / BM; nN = N / BM; nwg = nM * nN; G = G_; c = c_; }
    __device__ __forceinline__ bool next(int i, Unit& u) const {
        const long L = (long)i * G + c; if (L >= nwg) return false;
        int wgid = (int)L; { const int q = nwg / NXCD, r = nwg % NXCD, xcd = wgid % NXCD, off = wgid / NXCD; wgid = (xcd < r ? xcd * (q + 1) : r * (q + 1) + (xcd - r) * q) + off; }
        const int nig = WGM * nN, gid = wgid / nig, fm = gid * WGM, gsz = (nM - fm) < WGM ? (nM - fm) : WGM;
        u.pm = fm + ((wgid % nig) % gsz); u.pn = (wgid % nig) / gsz; u.z = 0;
        u.a = A + (size_t)u.pm * BM * lda * 2; u.b = B + (size_t)u.pn * BM * ldb * 2; return true;
    }
};

template <class Epi, class Sched>
__device__ __forceinline__ void gemm_phase(PG8_LAS unsigned char* lds, const int K, const int lda, const int ldb, const Sched& S, const Epi& E) {
    const int tid = threadIdx.x, wid = __builtin_amdgcn_readfirstlane(tid >> 6), lane = tid & 63, wr = wid >> 2, wc = wid & 3, fr = lane & 15, fq = lane >> 4;
    const int nt = K / BK;
    unsigned voffA[2], voffB[2];
#pragma unroll
    for (int i = 0; i < 2; ++i) { int R, C; stage_rc(tid * 16 + i * 8192, R, C); const int Rb = Epi::PERM ? ((R & ~31) + perm32(R & 31)) : R;
        voffA[i] = (unsigned)(R * lda + C) * 2u; voffB[i] = (unsigned)(Rb * ldb + C) * 2u; }
    const size_t kstep = (size_t)(BK * 2);
    const size_t hstepA = (size_t)HALF * lda * 2, hstepB = (size_t)HALF * ldb * 2;
    const unsigned ldsw = (unsigned)wid * 1024u;
    const int aoff = lds_byte(wr * 64 + fr, fq * 8), boff = lds_byte(wc * 32 + fr, fq * 8);
#define PG8_SA(b, h) (((b) * 2 + (h)) * HTB)
#define PG8_SB(b, h) ((4 + (b) * 2 + (h)) * HTB)
#define PG8_STAGE(bufoff, gbase, voff) do { _Pragma("unroll") for (int _i = 0; _i < 2; ++_i) \
        __builtin_amdgcn_global_load_lds((const unsigned*)((const char*)(gbase) + (voff)[_i]), (PG8_LAS unsigned*)(lds + (bufoff) + ldsw + _i * 8192), 16, 0, 0); } while (0)
#define PG8_LDA(dst, b, h) do { _Pragma("unroll") for (int m = 0; m < 4; ++m) _Pragma("unroll") for (int k = 0; k < 2; ++k) dst[m][k] = *(const PG8_LAS bf16x8*)(lds + PG8_SA(b, h) + aoff + m * 2048 + k * 1024); } while (0)
#define PG8_LDB(dst, b, h) do { _Pragma("unroll") for (int n = 0; n < 2; ++n) _Pragma("unroll") for (int k = 0; k < 2; ++k) dst[n][k] = *(const PG8_LAS bf16x8*)(lds + PG8_SB(b, h) + boff + n * 2048 + k * 1024); } while (0)
#define PG8_MMA(ai, bj, At, Bt) do { __builtin_amdgcn_s_setprio(1); _Pragma("unroll") for (int m = 0; m < 4; ++m) _Pragma("unroll") for (int n = 0; n < 2; ++n) _Pragma("unroll") for (int k = 0; k < 2; ++k) \
        acc[ai][bj][m][n] = __builtin_amdgcn_mfma_f32_16x16x32_bf16(Bt[n][k], At[m][k], acc[ai][bj][m][n], 0, 0, 0); __builtin_amdgcn_s_setprio(0); } while (0)
#define PG8_WAIT_V(n) asm volatile("s_waitcnt vmcnt(" #n ")" ::: "memory")
#define PG8_WAIT_L(n) asm volatile("s_waitcnt lgkmcnt(" #n ")" ::: "memory")
#define PG8_BAR __builtin_amdgcn_s_barrier()
#define PG8_SCHED __builtin_amdgcn_sched_barrier(0)
    Unit cur, nxt; int ui = 0;
    if (!S.next(0, cur)) return;
    f32x4 acc[2][2][4][2];
#pragma unroll
    for (int a = 0; a < 2; ++a)
#pragma unroll
        for (int b = 0; b < 2; ++b)
#pragma unroll
            for (int m = 0; m < 4; ++m)
#pragma unroll
                for (int n = 0; n < 2; ++n) acc[a][b][m][n] = (f32x4){0.f, 0.f, 0.f, 0.f};
    bf16x8 At[4][2], B0[2][2], B1[2][2];
    const char* cA = cur.a; const char* cB = cur.b;
    PG8_STAGE(PG8_SB(0, 0), cB, voffB); PG8_STAGE(PG8_SB(0, 1), cB + hstepB, voffB); PG8_STAGE(PG8_SA(0, 0), cA, voffA); PG8_STAGE(PG8_SA(0, 1), cA + hstepA, voffA);
    if (wr == 1) PG8_BAR;
    PG8_WAIT_V(2); PG8_BAR;
    PG8_STAGE(PG8_SB(1, 0), cB + kstep, voffB); PG8_STAGE(PG8_SA(1, 0), cA + kstep, voffA); PG8_STAGE(PG8_SB(1, 1), cB + hstepB + kstep, voffB);
    PG8_WAIT_V(6); PG8_BAR;
    for (;;) {
        const bool has_next = S.next(ui + 1, nxt);
        const char* nA = has_next ? nxt.a : cA; const char* nB = has_next ? nxt.b : cB;
        for (int t = 0; t < nt; t += 2) {
            const bool last = (t == nt - 2);
            const char* a1 = cA + (size_t)(t + 1) * kstep;
            const char* a2 = last ? nA : cA + (size_t)(t + 2) * kstep; const char* b2 = last ? nB : cB + (size_t)(t + 2) * kstep;
            const char* a3 = a2 + kstep; const char* b3 = b2 + kstep;
            PG8_LDB(B0, 0, 0); PG8_LDB(B1, 0, 1); PG8_SCHED; PG8_LDA(At, 0, 0); PG8_STAGE(PG8_SA(1, 1), a1 + hstepA, voffA);
            PG8_WAIT_V(8); PG8_WAIT_L(0); PG8_BAR; PG8_MMA(0, 0, At, B0); PG8_MMA(0, 1, At, B1); PG8_BAR; PG8_SCHED;
            PG8_LDA(At, 0, 1); PG8_STAGE(PG8_SB(0, 0), b2, voffB); PG8_STAGE(PG8_SB(0, 1), b2 + hstepB, voffB); PG8_STAGE(PG8_SA(0, 0), a2, voffA);
            PG8_WAIT_V(8); PG8_WAIT_L(0); PG8_BAR; PG8_MMA(1, 0, At, B0); PG8_MMA(1, 1, At, B1); PG8_BAR; PG8_SCHED;
            PG8_LDB(B0, 1, 0); PG8_LDB(B1, 1, 1); PG8_SCHED; PG8_LDA(At, 1, 0); PG8_STAGE(PG8_SA(0, 1), a2 + hstepA, voffA);
            PG8_WAIT_V(8); PG8_WAIT_L(0); PG8_BAR; PG8_MMA(0, 0, At, B0); PG8_MMA(0, 1, At, B1); PG8_BAR; PG8_SCHED;
            PG8_LDA(At, 1, 1); PG8_STAGE(PG8_SB(1, 0), b3, voffB); PG8_STAGE(PG8_SB(1, 1), b3 + hstepB, voffB); PG8_STAGE(PG8_SA(1, 0), a3, voffA);
            PG8_WAIT_V(8); PG8_WAIT_L(0); PG8_BAR; PG8_MMA(1, 0, At, B0); PG8_MMA(1, 1, At, B1); PG8_BAR; PG8_SCHED;
        }
        if (wr == 0) PG8_BAR;
        E(acc, cur, wr, wc, fr, fq, wid, lane);
        if (!has_next) break;
#pragma unroll
        for (int a = 0; a < 2; ++a)
#pragma unroll
            for (int b = 0; b < 2; ++b)
#pragma unroll
                for (int m = 0; m < 4; ++m)
#pragma unroll
                    for (int n = 0; n < 2; ++n) acc[a][b][m][n] = (f32x4){0.f, 0.f, 0.f, 0.f};
        cur = nxt; cA = nA; cB = nB; ++ui;
        if (wr == 1) PG8_BAR;
    }
    PG8_WAIT_V(0);
    PG8_BAR;
#undef PG8_SA
#undef PG8_SB
#undef PG8_STAGE
#undef PG8_LDA
#undef PG8_LDB
#undef PG8_MMA
#undef PG8_WAIT_V
#undef PG8_WAIT_L
#undef PG8_BAR
#undef PG8_SCHED
}
}

constexpr int NWAVES = 8;
constexpr int BATCH = 4, SEQ = 8192, D = 1024, M = BATCH * SEQ;
constexpr int FF = 2816, GU = 2 * FF, INC = 3584, NMEM = 256, MROWS = BATCH * NMEM;
constexpr int HGW = 512, HGH = 4, HGD = 128, SBW = 512, SBH = 8, SBD = 64, CHD = 256;
constexpr float EPS = 1e-6f, LOG2E = 1.4426950408889634f, LN2 = 0.6931471805599453f;
constexpr float SB_QSCALE = 0.125f * LOG2E;
constexpr float CA_QSCALE = 0.0625f * LOG2E;
constexpr float SB_STOP = 128.0f;

constexpr size_t MiB = 1u << 20;
constexpr size_t WS_CTL = 0, CTL_ZERO_BYTES = 2 * MiB;
constexpr size_t WS_SS = 1 * MiB;
constexpr size_t WS_WGU1 = 2 * MiB, WS_WD1 = 13 * MiB, WS_WIN = 19 * MiB, WS_WOUT = 26 * MiB, WS_WQ = 28 * MiB, WS_WKV = 30 * MiB, WS_WO = 34 * MiB, WS_WGU2 = 36 * MiB, WS_WD2 = 47 * MiB;
constexpr size_t WS_MN = 53 * MiB, WS_KVM = 55 * MiB, WS_DVEC = 59 * MiB;
constexpr size_t WS_WQK = 464 * MiB, WS_VWO = 472 * MiB;
constexpr size_t WS_XB = 64 * MiB;
constexpr size_t WS_HMID = 128 * MiB;
constexpr size_t WS_HQ = 128 * MiB, WS_LOGF = 160 * MiB, WS_HI = 224 * MiB, WS_HSG = 256 * MiB;
constexpr size_t WS_SBQ = 304 * MiB, WS_SBK = 336 * MiB, WS_SBV = 368 * MiB;
constexpr size_t WS_MIXED = 400 * MiB;
constexpr size_t WS_PM = 192 * MiB;
constexpr size_t WS_END = 480 * MiB;
constexpr int CW_TMO = 0, CW_CODE = 1, CW_SBQ = 64, CW_BAR = 4096;

constexpr int RING_BYTES = 131072;
constexpr int LDSCTL_OFF = RING_BYTES, MISC_OFF = LDSCTL_OFF + 320;
constexpr int EPI_OFF = RING_BYTES + 1024;
constexpr int LDS_BYTES = 147456;

#define GAS __attribute__((address_space(1)))
#define LAS __attribute__((address_space(3)))
typedef unsigned short bf16;
typedef unsigned v4u __attribute__((ext_vector_type(4)));
typedef float f32x4 __attribute__((ext_vector_type(4)));
typedef GAS unsigned gu32;
#define RLX_AGENT __ATOMIC_RELAXED, __HIP_MEMORY_SCOPE_AGENT
#define LDS_WAIT() asm volatile("s_waitcnt lgkmcnt(0)" ::: "memory")
#define VM_WAIT() asm volatile("s_waitcnt vmcnt(0)" ::: "memory")
__device__ __forceinline__ unsigned f2bf(float f) { unsigned u = __builtin_bit_cast(unsigned, f); return (u + 0x7fffu + ((u >> 16) & 1u)) >> 16; }
__device__ __forceinline__ unsigned pk2(float lo, float hi) { return f2bf(lo) | (f2bf(hi) << 16); }
__device__ __forceinline__ float bf_lo(unsigned w) { return __builtin_bit_cast(float, w << 16); }
__device__ __forceinline__ float bf_hi(unsigned w) { return __builtin_bit_cast(float, w & 0xffff0000u); }
__device__ __forceinline__ float bf2f(bf16 h) { return __builtin_bit_cast(float, (unsigned)h << 16); }
__device__ __forceinline__ float ex2(float x) { return __builtin_amdgcn_exp2f(x); }
__device__ __forceinline__ float lg2(float x) { return __builtin_amdgcn_logf(x); }
__device__ __forceinline__ float rcpf_(float x) { return __builtin_amdgcn_rcpf(x); }
__device__ __forceinline__ float sigmoidf_(float v) { return rcpf_(1.0f + ex2(-v * LOG2E)); }
__device__ __forceinline__ float siluf_(float v) { return v * sigmoidf_(v); }
__device__ __forceinline__ float rdlane(float v, int l) { return __builtin_bit_cast(float, __builtin_amdgcn_readlane(__builtin_bit_cast(int, v), l)); }
__device__ __forceinline__ float wave_sum(float v) {
#pragma unroll
    for (int o = 1; o < 64; o <<= 1) v += __shfl_xor(v, o);
    return v;
}

#define XB_TMO      128
#define XB_XCNT(j)  (256  + 64 * (j))
#define XB_XSUB(j)  (1280 + 64 * (j))
#define XB_XGEN(j)  (2304 + 64 * (j))
#define XB_TOP      3328
#define XB_TOPGEN   3392
#define XCD_BAR_WORDS 3456
#define XB_SPIN_CAP (1u << 18)
__device__ __forceinline__ unsigned xb_ld(unsigned* p)              { return __hip_atomic_load(p, __ATOMIC_RELAXED, __HIP_MEMORY_SCOPE_AGENT); }
__device__ __forceinline__ unsigned xb_add(unsigned* p, unsigned v) { return __hip_atomic_fetch_add(p, v, __ATOMIC_RELAXED, __HIP_MEMORY_SCOPE_AGENT); }
__device__ __forceinline__ unsigned xb_xcc_id() { return (unsigned)__builtin_amdgcn_s_getreg((3 << 11) | 20) & 0xFu; }
#define XB_SPIN(cond, bar) do { unsigned _sp = 0; while (cond) { __builtin_amdgcn_s_sleep(1); \
    if ((++_sp & 255u) == 0u) { if (xb_ld(&(bar)[XB_TMO])) break; if (_sp > XB_SPIN_CAP) { atomicAdd(&(bar)[XB_TMO], 1u); break; } } } } while (0)
struct XcdBarrier { unsigned* bar; unsigned x; volatile LAS unsigned* st; };
__device__ __forceinline__ XcdBarrier xcd_barrier_post(unsigned* bar, volatile LAS unsigned* st) {
    XcdBarrier b; b.bar = bar; b.x = xb_xcc_id(); b.st = st;
    if (threadIdx.x == 0) (void)xb_add(&bar[XB_XCNT(b.x)], 1u);
    return b;
}
__device__ __forceinline__ void xcd_barrier_complete(unsigned* bar, unsigned x, unsigned& nloc, unsigned& nx) {
    const unsigned G = gridDim.x * gridDim.y * gridDim.z;
    unsigned sum, cnt, mine, sp = 0u;
    for (;;) {
        sum = 0u; cnt = 0u; mine = 0u;
#pragma unroll
        for (unsigned j = 0; j < 16; ++j) { const unsigned c = xb_ld(&bar[XB_XCNT(j)]); sum += c; cnt += (c > 0u) ? 1u : 0u; mine = (j == x) ? c : mine; }
        if (sum == G) break;
        __builtin_amdgcn_s_sleep(1);
        if ((++sp & 255u) == 0u) { if (xb_ld(&bar[XB_TMO])) break; if (sp > XB_SPIN_CAP) { atomicAdd(&bar[XB_TMO], 1u); break; } }
    }
    nloc = mine > 0u ? mine : 1u; nx = cnt > 0u ? cnt : 1u;
}
__device__ __forceinline__ void xcd_barrier(const XcdBarrier& b) {
    asm volatile("s_waitcnt vmcnt(0)" ::: "memory");
    __syncthreads();
    if (threadIdx.x == 0) {
        unsigned* bar = b.bar;
        __builtin_amdgcn_s_waitcnt(0);
        unsigned nloc = b.st[0], nx = b.st[1];
        if (nloc == 0u) { xcd_barrier_complete(bar, b.x, nloc, nx); b.st[0] = nloc; b.st[1] = nx; }
        const unsigned old = xb_add(&bar[XB_XSUB(b.x)], 1u);
        const unsigned gen = old / nloc;
        if (old + 1u == (gen + 1u) * nloc) {
            __builtin_amdgcn_fence(__ATOMIC_RELEASE, "agent");
            asm volatile("s_waitcnt vmcnt(0)" ::: "memory");
            const unsigned og = xb_add(&bar[XB_TOP], 1u);
            const unsigned tg = og / nx;
            if (og + 1u == (tg + 1u) * nx) xb_add(&bar[XB_TOPGEN], 1u);
            else XB_SPIN(xb_ld(&bar[XB_TOPGEN]) == tg, bar);
            __builtin_amdgcn_fence(__ATOMIC_ACQUIRE, "agent");
            xb_add(&bar[XB_XGEN(b.x)], 1u);
            asm volatile("s_waitcnt vmcnt(0)" ::: "memory");
        } else {
            XB_SPIN(xb_ld(&bar[XB_XGEN(b.x)]) == gen, bar);
            __builtin_amdgcn_fence(__ATOMIC_ACQUIRE, "agent");
            asm volatile("s_waitcnt vmcnt(0)" ::: "memory");
        }
    }
    __syncthreads();
}

using pg8::f32x4; using pg8::u32x4; using pg8::Unit; using pg8::cvt_pk_bf16;
typedef f32x4 acc_t[2][2][4][2];
__device__ __forceinline__ float rs_of(const float* ss, int row) { return __builtin_amdgcn_rsqf(ss[row] * (1.0f / (float)D) + EPS); }
__device__ __forceinline__ u32x4 pack8(const f32x4 a, const f32x4 b) { u32x4 w; w.x = cvt_pk_bf16(a[0], a[1]); w.y = cvt_pk_bf16(a[2], a[3]); w.z = cvt_pk_bf16(b[0], b[1]); w.w = cvt_pk_bf16(b[2], b[3]); return w; }

struct EpiSwiglu {
    static constexpr bool PERM = true;
    bf16* H; const float* ss;
    __device__ __forceinline__ void operator()(acc_t& acc, const Unit& u, int wr, int wc, int fr, int fq, int, int) const {
        const int row0 = u.pm * 256 + wr * 64 + fr, col0 = u.pn * 128 + wc * 32 + 8 * fq;
#pragma unroll
        for (int ai = 0; ai < 2; ++ai)
#pragma unroll
            for (int m = 0; m < 4; ++m) { const int row = row0 + ai * 128 + m * 16; const float r = rs_of(ss, row);
                f32x4 h[2];
#pragma unroll
                for (int n = 0; n < 2; ++n) { const f32x4 g = acc[ai][0][m][n] * r, up = acc[ai][1][m][n] * r;
#pragma unroll
                    for (int e = 0; e < 4; ++e) h[n][e] = siluf_(g[e]) * up[e]; }
                *(u32x4*)(H + (size_t)row * FF + col0) = pack8(h[0], h[1]); }
    }
};
template <bool IN_F32> struct EpiResid {
    static constexpr bool PERM = true;
    const void* xin; float* xf; bf16* xb; float* ssout; float alpha;
    __device__ __forceinline__ void operator()(acc_t& acc, const Unit& u, int wr, int wc, int fr, int fq, int, int) const {
        const int row0 = u.pm * 256 + wr * 64 + fr, col0 = u.pn * 256 + wc * 32 + 8 * fq;
#pragma unroll
        for (int ai = 0; ai < 2; ++ai)
#pragma unroll
            for (int m = 0; m < 4; ++m) { const int row = row0 + ai * 128 + m * 16; float part = 0.f;
#pragma unroll
                for (int bj = 0; bj < 2; ++bj) { const size_t off = (size_t)row * D + col0 + bj * 128;
                    f32x4 a0, a1;
                    if (IN_F32) { a0 = *(const f32x4*)((const float*)xin + off); a1 = *(const f32x4*)((const float*)xin + off + 4); }
                    else { const u32x4 w = *(const u32x4*)((const bf16*)xin + off); a0 = (f32x4){bf_lo(w.x), bf_hi(w.x), bf_lo(w.y), bf_hi(w.y)}; a1 = (f32x4){bf_lo(w.z), bf_hi(w.z), bf_lo(w.w), bf_hi(w.w)}; }
                    const f32x4 o0 = a0 + acc[ai][bj][m][0] * alpha, o1 = a1 + acc[ai][bj][m][1] * alpha;
                    if (xf) { *(f32x4*)(xf + off) = o0; *(f32x4*)(xf + off + 4) = o1; }
                    if (xb) *(u32x4*)(xb + off) = pack8(o0, o1);
                    part += (o0[0] * o0[0] + o0[1] * o0[1]) + (o0[2] * o0[2] + o0[3] * o0[3]) + (o1[0] * o1[0] + o1[1] * o1[1]) + (o1[2] * o1[2] + o1[3] * o1[3]); }
                if (ssout) { part += __shfl_xor(part, 16); part += __shfl_xor(part, 32); if (fq == 0) atomicAdd(ssout + row, part); } }
    }
};
struct EpiPlain {
    static constexpr bool PERM = true;
    bf16* O; int ldc; const float* ss; float cs; size_t zstride;
    __device__ __forceinline__ void operator()(acc_t& acc, const Unit& u, int wr, int wc, int fr, int fq, int, int) const {
        const int row0 = u.pm * 256 + wr * 64 + fr, col0 = u.pn * 256 + wc * 32 + 8 * fq; bf16* Oz = O + (size_t)u.z * zstride;
#pragma unroll
        for (int ai = 0; ai < 2; ++ai)
#pragma unroll
            for (int m = 0; m < 4; ++m) { const int row = row0 + ai * 128 + m * 16; const float r = (ss ? rs_of(ss, row) : 1.0f) * cs;
#pragma unroll
                for (int bj = 0; bj < 2; ++bj) *(u32x4*)(Oz + (size_t)row * ldc + col0 + bj * 128) = pack8(acc[ai][bj][m][0] * r, acc[ai][bj][m][1] * r); }
    }
};
struct EpiWin {
    static constexpr bool PERM = true;
    const float* ss; const float* lbraw; bf16* hq; float* logf; bf16* hi; bf16* hsg; bf16* sbq; bf16* sbk; bf16* sbv;
    __device__ __forceinline__ void operator()(acc_t& acc, const Unit& u, int wr, int wc, int fr, int fq, int, int) const {
        const int row0 = u.pm * 256 + wr * 64 + fr; const int seg = u.pn >> 1; const int cseg0 = (u.pn & 1) * 256 + wc * 32 + 8 * fq;
        if (seg == 1) {
            float lb[2][8];
#pragma unroll
            for (int bj = 0; bj < 2; ++bj)
#pragma unroll
                for (int e = 0; e < 8; ++e) { const int c = cseg0 + bj * 128 + e; lb[bj][e] = rcpf_(1.0f + ex2((lbraw[HGW + c] - lbraw[c]) * LOG2E)); }
#pragma unroll
            for (int ai = 0; ai < 2; ++ai)
#pragma unroll
                for (int m = 0; m < 4; ++m) { const int row = row0 + ai * 128 + m * 16; const float r = rs_of(ss, row);
#pragma unroll
                    for (int bj = 0; bj < 2; ++bj) { f32x4 o[2];
#pragma unroll
                        for (int n = 0; n < 2; ++n)
#pragma unroll
                            for (int e = 0; e < 4; ++e) { const float v = acc[ai][bj][m][n][e] * r; const float l = lb[bj][4 * n + e]; const float f = l + (1.0f - l) * sigmoidf_(v); o[n][e] = lg2(f) * LN2; }
                        float* p = logf + (size_t)row * HGW + cseg0 + bj * 128; *(f32x4*)p = o[0]; *(f32x4*)(p + 4) = o[1]; } }
            return;
        }
#pragma unroll
        for (int ai = 0; ai < 2; ++ai)
#pragma unroll
            for (int m = 0; m < 4; ++m) { const int row = row0 + ai * 128 + m * 16; const float r = rs_of(ss, row);
#pragma unroll
                for (int bj = 0; bj < 2; ++bj) { f32x4 v0 = acc[ai][bj][m][0] * r, v1 = acc[ai][bj][m][1] * r; const int cs = cseg0 + bj * 128;
                    bf16* dst;
                    if (seg == 0) dst = hq + (size_t)row * HGW + cs;
                    else if (seg == 2) dst = hi + (size_t)row * HGW + cs;
                    else if (seg == 3) { dst = hsg + (size_t)row * HGW + cs;
#pragma unroll
                        for (int e = 0; e < 4; ++e) { v0[e] = siluf_(v0[e]); v1[e] = siluf_(v1[e]); } }
                    else { const int b = row >> 13, s = row & (SEQ - 1), head = cs >> 6, d = cs & 63; const size_t o = ((size_t)(b * SBH + head) * SEQ + s) * SBD + d;
                        if (seg == 4) { dst = sbq + o; v0 = v0 * SB_QSCALE; v1 = v1 * SB_QSCALE; } else if (seg == 5) dst = sbk + o; else dst = sbv + o; }
                    *(u32x4*)dst = pack8(v0, v1); } }
    }
};
struct EpiSoftmax {
    static constexpr bool PERM = true;
    bf16* P; PG8_LAS unsigned char* xl; const float* ss;
    __device__ __forceinline__ void operator()(acc_t& acc, const Unit& u, int wr, int wc, int fr, int fq, int, int) const {
        typedef float f32x2v __attribute__((ext_vector_type(2)));
        PG8_LAS f32x2v* X = (PG8_LAS f32x2v*)xl;
        float mw[2][4];
#pragma unroll
        for (int ai = 0; ai < 2; ++ai)
#pragma unroll
            for (int m = 0; m < 4; ++m) { float mx = -3.0e38f; const float rsc = rs_of(ss, u.pm * 256 + ai * 128 + wr * 64 + m * 16 + fr);
#pragma unroll
                for (int bj = 0; bj < 2; ++bj)
#pragma unroll
                    for (int n = 0; n < 2; ++n) { const f32x4 v = acc[ai][bj][m][n] * rsc; acc[ai][bj][m][n] = v; mx = fmaxf(fmaxf(fmaxf(mx, v[0]), fmaxf(v[1], v[2])), v[3]); }
                mx = fmaxf(mx, __shfl_xor(mx, 16)); mx = fmaxf(mx, __shfl_xor(mx, 32));
                float s = 0.f;
#pragma unroll
                for (int bj = 0; bj < 2; ++bj)
#pragma unroll
                    for (int n = 0; n < 2; ++n) { f32x4 v = acc[ai][bj][m][n];
#pragma unroll
                        for (int e = 0; e < 4; ++e) { v[e] = ex2(v[e] - mx); s += v[e]; }
                        acc[ai][bj][m][n] = v; }
                s += __shfl_xor(s, 16); s += __shfl_xor(s, 32);
                if (fq == 0) X[(ai * 128 + wr * 64 + m * 16 + fr) * 4 + wc] = (f32x2v){mx, s};
                mw[ai][m] = mx; }
        asm volatile("s_waitcnt lgkmcnt(0)" ::: "memory"); __builtin_amdgcn_s_barrier(); asm volatile("" ::: "memory");
        const int row0 = u.pm * 256 + wr * 64 + fr, col0 = u.pn * 256 + wc * 32 + 8 * fq;
#pragma unroll
        for (int ai = 0; ai < 2; ++ai)
#pragma unroll
            for (int m = 0; m < 4; ++m) { const int rl = ai * 128 + wr * 64 + m * 16 + fr;
                const f32x2v a = X[rl * 4 + 0], b = X[rl * 4 + 1], c = X[rl * 4 + 2], d = X[rl * 4 + 3];
                const float mt = fmaxf(fmaxf(a.x, b.x), fmaxf(c.x, d.x));
                const float tot = a.y * ex2(a.x - mt) + b.y * ex2(b.x - mt) + c.y * ex2(c.x - mt) + d.y * ex2(d.x - mt);
                const float f = ex2(mw[ai][m] - mt) * rcpf_(tot);
                const int row = row0 + ai * 128 + m * 16;
#pragma unroll
                for (int bj = 0; bj < 2; ++bj) *(u32x4*)(P + (size_t)row * D + col0 + bj * 128) = pack8(acc[ai][bj][m][0] * f, acc[ai][bj][m][1] * f); }
    }
};

struct CrossOrder {
    const char* A; const char* B; int G, c;
    __device__ __forceinline__ bool next(int i, Unit& u) const {
        const int L = i * G + c; if (L >= 512) return false;
        u.pm = L >> 2; u.pn = L & 3; u.z = 0; const int b = u.pm >> 5;
        u.a = A + (size_t)u.pm * 256 * D * 2; u.b = B + ((size_t)b * D + u.pn * 256) * D * 2;
        return true;
    }
};
struct OneUnit {
    const char* a; const char* b; int pm, pn, z;
    __device__ __forceinline__ bool next(int i, Unit& u) const { if (i > 0) return false; u.pm = pm; u.pn = pn; u.z = z; u.a = a; u.b = b; return true; }
};

typedef pg8::bf16x8 bf16x8;
typedef float f32x16 __attribute__((ext_vector_type(16)));
typedef short s16x4 __attribute__((ext_vector_type(4)));
typedef float f32x2_t __attribute__((ext_vector_type(2)));
typedef __bf16 bf16x2_t __attribute__((ext_vector_type(2)));
typedef unsigned u32x2 __attribute__((ext_vector_type(2)));
__device__ __forceinline__ unsigned cvtpk(float lo, float hi) { f32x2_t v = {lo, hi}; bf16x2_t b = __builtin_convertvector(v, bf16x2_t); return __builtin_bit_cast(unsigned, b); }
__device__ __forceinline__ s16x4 ldtr(LAS const unsigned char* p) { return __builtin_bit_cast(s16x4, __builtin_amdgcn_ds_read_tr16_b64_v4i16((LAS s16x4*)p)); }
__device__ __forceinline__ int crow(int r, int hi) { return (r & 3) + 8 * (r >> 2) + 4 * hi; }
#define MFMA32(a, b, c) __builtin_amdgcn_mfma_f32_32x32x16_bf16((a), (b), (c), 0, 0, 0)
__device__ __forceinline__ bf16x8 trfrag(LAS const unsigned char* tile, int pitch, int xbase, int k0, int k1, int lane) {
    const int colb = (xbase + 16 * ((lane >> 4) & 1) + 4 * (lane & 3)) * 2, rq = (lane & 15) >> 2;
    const s16x4 lo = ldtr(tile + (k0 + rq) * pitch + colb), hi = ldtr(tile + (k1 + rq) * pitch + colb);
    return (bf16x8){lo[0], lo[1], lo[2], lo[3], hi[0], hi[1], hi[2], hi[3]};
}
__device__ __forceinline__ int hsw(int row) { return ((row & 3) << 2) | ((row >> 2) & 3); }
__device__ __forceinline__ int hoff(int row, int col) { return row * 256 + ((((col >> 3) ^ hsw(row))) << 4) + (col & 7) * 2; }
__device__ __forceinline__ bf16x8 trfrag_sw(LAS const unsigned char* tile, int xbase, int k0, int k1, int lane) {
    const int col = xbase + 16 * ((lane >> 4) & 1) + 4 * (lane & 3), rq = (lane & 15) >> 2;
    const s16x4 lo = ldtr(tile + hoff(k0 + rq, col)), hi = ldtr(tile + hoff(k1 + rq, col));
    return (bf16x8){lo[0], lo[1], lo[2], lo[3], hi[0], hi[1], hi[2], hi[3]};
}
template <int S8> __device__ __forceinline__ bf16x8 acc_frag(const f32x16& v) {
    pg8::u32x4 w; w.x = cvtpk(v[8 * S8 + 0], v[8 * S8 + 1]); w.y = cvtpk(v[8 * S8 + 2], v[8 * S8 + 3]); w.z = cvtpk(v[8 * S8 + 4], v[8 * S8 + 5]); w.w = cvtpk(v[8 * S8 + 6], v[8 * S8 + 7]);
    return __builtin_bit_cast(bf16x8, w);
}
template <int S8> __device__ __forceinline__ void acc_frag_hl(const f32x16& v, bf16x8& H, bf16x8& L) {
    pg8::u32x4 hw, lw;
#pragma unroll
    for (int p = 0; p < 4; ++p) { const float a = v[8 * S8 + 2 * p], b = v[8 * S8 + 2 * p + 1]; const unsigned hp = cvtpk(a, b); hw[p] = hp; lw[p] = cvtpk(a - bf_lo(hp), b - bf_hi(hp)); }
    H = __builtin_bit_cast(bf16x8, hw); L = __builtin_bit_cast(bf16x8, lw);
}
__device__ __forceinline__ float softplus2(float z) { return fmaxf(z, 0.f) + lg2(1.0f + ex2(-fabsf(z))); }

__device__ __forceinline__ void sb_qblock(const bf16* SBQ, const bf16* SBK, const bf16* SBV, const float* gsb, bf16* MIXED, int bh, int qi, LAS unsigned char* vl, int lane) {
    const int r32 = lane & 31, hi = lane >> 5, q0 = qi * 32, b = bh >> 3, h = bh & 7;
    const bf16* Qb = SBQ + ((size_t)bh * SEQ + q0) * SBD;
    const bf16* Kh = SBK + (size_t)bh * SEQ * SBD; const bf16* Vh = SBV + (size_t)bh * SEQ * SBD;
    bf16x8 qf[4], kf[4];
#pragma unroll
    for (int ks = 0; ks < 4; ++ks) { qf[ks] = *(const bf16x8*)(Qb + r32 * SBD + ks * 16 + hi * 8); kf[ks] = *(const bf16x8*)(Kh + (size_t)(q0 + r32) * SBD + ks * 16 + hi * 8); }
    bf16x8 tri[2];
#pragma unroll
    for (int s8 = 0; s8 < 2; ++s8)
#pragma unroll
        for (int j = 0; j < 8; ++j) { const int jk = 16 * s8 + 8 * (j >> 2) + 4 * hi + (j & 3); tri[s8][j] = jk >= r32 ? (short)0x3F80 : (short)0; }
    f32x16 ot0 = {}, ot1 = {}; float carry = 0.f;
    for (int kb = qi; kb >= 0; --kb) {
        const bf16* Vt = Vh + (size_t)kb * 32 * SBD;
        v4u vv[4];
#pragma unroll
        for (int i = 0; i < 4; ++i) vv[i] = *(const v4u*)(Vt + (i * 64 + lane) * 8);
        f32x16 st = {};
#pragma unroll
        for (int ks = 0; ks < 4; ++ks) st = MFMA32(kf[ks], qf[ks], st);
        if (kb > 0) {
#pragma unroll
            for (int ks = 0; ks < 4; ++ks) kf[ks] = *(const bf16x8*)(Kh + (size_t)((kb - 1) * 32 + r32) * SBD + ks * 16 + hi * 8);
        }
        const int qlim = kb == qi ? r32 - 4 * hi : 4096;
        f32x16 sp;
#pragma unroll
        for (int r = 0; r < 16; ++r) sp[r] = ((r & 3) + 8 * (r >> 2)) < qlim ? softplus2(st[r]) : 0.f;
        bf16x8 H0, H1, L0, L1;
        acc_frag_hl<0>(sp, H0, L0); acc_frag_hl<1>(sp, H1, L1);
        f32x16 c;
#pragma unroll
        for (int r = 0; r < 16; ++r) c[r] = carry;
        c = MFMA32(tri[0], H0, c); c = MFMA32(tri[1], H1, c); c = MFMA32(tri[0], L0, c); c = MFMA32(tri[1], L1, c);
        f32x16 w;
#pragma unroll
        for (int r = 0; r < 16; ++r) w[r] = ((r & 3) + 8 * (r >> 2)) < qlim ? ex2(st[r] - c[r]) : 0.f;
        carry = __shfl(c[0], r32);
        const bf16x8 p0 = acc_frag<0>(w), p1 = acc_frag<1>(w);
        asm volatile("" ::: "memory");
#pragma unroll
        for (int i = 0; i < 4; ++i) *(LAS v4u*)(vl + (i * 64 + lane) * 16) = vv[i];
        asm volatile("" ::: "memory");
        ot0 = MFMA32(trfrag(vl, 128, 0, 4 * hi, 8 + 4 * hi, lane), p0, ot0);        ot1 = MFMA32(trfrag(vl, 128, 32, 4 * hi, 8 + 4 * hi, lane), p0, ot1);
        ot0 = MFMA32(trfrag(vl, 128, 0, 16 + 4 * hi, 24 + 4 * hi, lane), p1, ot0);  ot1 = MFMA32(trfrag(vl, 128, 32, 16 + 4 * hi, 24 + 4 * hi, lane), p1, ot1);
        asm volatile("" ::: "memory");
        if (__all(carry > SB_STOP)) break;
    }
    float ssq = 0.f;
#pragma unroll
    for (int r = 0; r < 16; ++r) ssq += ot0[r] * ot0[r] + ot1[r] * ot1[r];
    ssq += __shfl_xor(ssq, 32);
    const float rstd = __builtin_amdgcn_rsqf(ssq * (1.0f / (float)SBD) + EPS);
    bf16* orow = MIXED + ((size_t)b * SEQ + q0 + r32) * D + HGW + h * SBD;
#pragma unroll
    for (int rg = 0; rg < 4; ++rg) { const int d0 = 8 * rg + 4 * hi;
        const f32x4 g0 = *(const f32x4*)(gsb + h * SBD + d0), g1 = *(const f32x4*)(gsb + h * SBD + 32 + d0);
        u32x2 a, c2; a.x = cvtpk(ot0[4 * rg] * rstd * g0[0], ot0[4 * rg + 1] * rstd * g0[1]); a.y = cvtpk(ot0[4 * rg + 2] * rstd * g0[2], ot0[4 * rg + 3] * rstd * g0[3]);
        c2.x = cvtpk(ot1[4 * rg] * rstd * g1[0], ot1[4 * rg + 1] * rstd * g1[1]); c2.y = cvtpk(ot1[4 * rg + 2] * rstd * g1[2], ot1[4 * rg + 3] * rstd * g1[3]);
        *(u32x2*)(orow + d0) = a; *(u32x2*)(orow + 32 + d0) = c2; }
}

constexpr int HG_T0 = 0, HG_T1 = 16384, HG_T2 = 32768, HG_T3 = 49152, HG_TOT = 65536, HG_SSQ = HG_TOT + 2048;
__device__ __forceinline__ void hg_front(const float* LOGF, const bf16* HI, size_t rbase, int h, LAS unsigned char* lds, int tid, float (&lf)[16], float (&bb)[16], float& all, float& mid) {
    const int ch = tid & 127, tg = tid >> 7;
    v4u vt[2];
#pragma unroll
    for (int i = 0; i < 2; ++i) { const int chunk = tid + 512 * i, row = chunk >> 4, cc = chunk & 15; vt[i] = *(const v4u*)(HI + (rbase + row) * HGW + h * HGD + cc * 8); }
#pragma unroll
    for (int k = 0; k < 16; ++k) { lf[k] = LOGF[(rbase + tg * 16 + k) * HGW + h * HGD + ch]; }
    float run = 0.f;
#pragma unroll
    for (int k = 0; k < 16; ++k) { run += lf[k]; bb[k] = run; }
    LAS float* TOT = (LAS float*)(lds + HG_TOT);
    TOT[tg * 128 + ch] = run;
#pragma unroll
    for (int i = 0; i < 2; ++i) { const int chunk = tid + 512 * i, row = chunk >> 4, cc = chunk & 15; *(LAS v4u*)(lds + HG_T3 + hoff(row, cc * 8)) = vt[i]; }
    __syncthreads();
    const float t0 = TOT[ch], t1 = TOT[128 + ch], t2 = TOT[256 + ch], t3 = TOT[384 + ch];
    const float pre = tg == 0 ? 0.f : tg == 1 ? t0 : tg == 2 ? t0 + t1 : t0 + t1 + t2;
    all = (t0 + t1) + (t2 + t3); mid = t0 + t1;
#pragma unroll
    for (int k = 0; k < 16; ++k) bb[k] += pre;
}
__device__ __forceinline__ void hg_pass1(const float* LOGF, const bf16* HI, bf16* ST, float* DVEC, int item, LAS unsigned char* lds, int tid, int wave, int lane) {
    const int c = item & 127, bh = item >> 7, b = bh >> 2, h = bh & 3; const size_t rbase = (size_t)b * SEQ + c * 64;
    const int ch = tid & 127, tg = tid >> 7, r32 = lane & 31, hi = lane >> 5;
    float lf[16], bb[16], all, mid;
    hg_front(LOGF, HI, rbase, h, lds, tid, lf, bb, all, mid);
#pragma unroll
    for (int k = 0; k < 16; ++k) { const float f = ex2(lf[k] * LOG2E); const float kd = (1.0f - f) * ex2((all - bb[k]) * LOG2E);
        *(LAS bf16*)(lds + HG_T0 + hoff(tg * 16 + k, ch)) = (bf16)f2bf(kd); }
    if (tg == 0) DVEC[(size_t)item * HGD + ch] = ex2(all * LOG2E);
    __syncthreads();
    const int dkb = wave >> 1;
#pragma unroll
    for (int tl = 0; tl < 2; ++tl) { const int dvb = 2 * (wave & 1) + tl; f32x16 acc = {};
#pragma unroll
        for (int ks = 0; ks < 4; ++ks) { const int k0 = 16 * ks + 8 * hi;
            acc = MFMA32(trfrag_sw(lds + HG_T0, 32 * dkb, k0, k0 + 4, lane), trfrag_sw(lds + HG_T3, 32 * dvb, k0, k0 + 4, lane), acc); }
        bf16* dst = ST + ((size_t)item * HGD + 32 * dvb + r32) * HGD + 32 * dkb;
#pragma unroll
        for (int rg = 0; rg < 4; ++rg) { u32x2 w; w.x = cvtpk(acc[4 * rg], acc[4 * rg + 1]); w.y = cvtpk(acc[4 * rg + 2], acc[4 * rg + 3]); *(u32x2*)(dst + 8 * rg + 4 * hi) = w; } }
    __syncthreads();
}
__device__ __forceinline__ void hg_pass3(const float* LOGF, const bf16* HQ, const bf16* HI, const bf16* HSG, const bf16* ST, const float* ghg, bf16* MIXED, int item, LAS unsigned char* lds, int tid, int wave, int lane) {
    const int c = item & 127, bh = item >> 7, b = bh >> 2, h = bh & 3; const size_t rbase = (size_t)b * SEQ + c * 64;
    const int ch = tid & 127, tg = tid >> 7, r32 = lane & 31, hi = lane >> 5;
    const int dvb = wave >> 1, tb = wave & 1, tl = 32 * tb + r32; const size_t row = rbase + tl;
    bf16x8 sf[8];
#pragma unroll
    for (int ks = 0; ks < 8; ++ks) sf[ks] = *(const bf16x8*)(ST + ((size_t)item * HGD + 32 * dvb + r32) * HGD + 16 * ks + 8 * hi);
    bf16 qraw[16];
#pragma unroll
    for (int k = 0; k < 16; ++k) qraw[k] = HQ[(rbase + tg * 16 + k) * HGW + h * HGD + ch];
    u32x2 sgv[4]; f32x4 gv[4];
#pragma unroll
    for (int rg = 0; rg < 4; ++rg) { const int col = h * HGD + 32 * dvb + 8 * rg + 4 * hi; sgv[rg] = *(const u32x2*)(HSG + row * HGW + col); gv[rg] = *(const f32x4*)(ghg + col); }
    float lf[16], bb[16], all, mid;
    hg_front(LOGF, HI, rbase, h, lds, tid, lf, bb, all, mid);
#pragma unroll
    for (int k = 0; k < 16; ++k) { const int t = tg * 16 + k; const float q = bf2f(qraw[k]);
        const float f = ex2(lf[k] * LOG2E); const float e1 = fminf(fmaxf(bb[k] - mid, -80.f), 80.f) * LOG2E;
        *(LAS bf16*)(lds + HG_T0 + hoff(t, ch)) = (bf16)f2bf(q * ex2(bb[k] * LOG2E));
        *(LAS bf16*)(lds + HG_T1 + hoff(t, ch)) = (bf16)f2bf(q * ex2(e1));
        *(LAS bf16*)(lds + HG_T2 + hoff(t, ch)) = (bf16)f2bf((1.0f - f) * ex2(-e1)); }
    __syncthreads();
    f32x16 ot = {};
#pragma unroll
    for (int ks = 0; ks < 8; ++ks)
        ot = MFMA32(sf[ks], *(const LAS bf16x8*)(lds + HG_T0 + hoff(32 * tb + r32, 16 * ks + 8 * hi)), ot);
#pragma unroll
    for (int sb = 0; sb < 2; ++sb) {
        if (sb <= tb) {
            f32x16 at = {};
#pragma unroll
            for (int ks = 0; ks < 8; ++ks)
                at = MFMA32(*(const LAS bf16x8*)(lds + HG_T2 + hoff(32 * sb + r32, 16 * ks + 8 * hi)), *(const LAS bf16x8*)(lds + HG_T1 + hoff(32 * tb + r32, 16 * ks + 8 * hi)), at);
            if (sb == tb) {
#pragma unroll
                for (int r = 0; r < 16; ++r) at[r] = ((r & 3) + 8 * (r >> 2)) <= r32 - 4 * hi ? at[r] : 0.f;
            }
            const bf16x8 p0 = acc_frag<0>(at), p1 = acc_frag<1>(at);
            ot = MFMA32(trfrag_sw(lds + HG_T3, 32 * dvb, 32 * sb + 4 * hi, 32 * sb + 8 + 4 * hi, lane), p0, ot);
            ot = MFMA32(trfrag_sw(lds + HG_T3, 32 * dvb, 32 * sb + 16 + 4 * hi, 32 * sb + 24 + 4 * hi, lane), p1, ot);
        }
    }
    float ssq = 0.f;
#pragma unroll
    for (int r = 0; r < 16; ++r) ssq += ot[r] * ot[r];
    ssq += __shfl_xor(ssq, 32);
    LAS float* SSQ = (LAS float*)(lds + HG_SSQ);
    if (hi == 0) SSQ[dvb * 64 + tl] = ssq;
    __syncthreads();
    const float rstd = __builtin_amdgcn_rsqf(((SSQ[tl] + SSQ[64 + tl]) + (SSQ[128 + tl] + SSQ[192 + tl])) * (1.0f / (float)HGD) + EPS);
#pragma unroll
    for (int rg = 0; rg < 4; ++rg) { const int col = h * HGD + 32 * dvb + 8 * rg + 4 * hi; const f32x4 g = gv[rg]; const u32x2 sg = sgv[rg];
        u32x2 w; w.x = cvtpk(ot[4 * rg] * rstd * g[0] * bf_lo(sg.x), ot[4 * rg + 1] * rstd * g[1] * bf_hi(sg.x)); w.y = cvtpk(ot[4 * rg + 2] * rstd * g[2] * bf_lo(sg.y), ot[4 * rg + 3] * rstd * g[3] * bf_hi(sg.y));
        *(u32x2*)(MIXED + row * D + col) = w; }
    __syncthreads();
}

struct Args { const float* in[20]; float* out; unsigned char* ws; int ph_lo, ph_hi; };

__device__ __forceinline__ void transpose_item(const float* W, int K, int N, bf16* WT, const float* gain, int mode, LAS float* scr, int item, int lane) {
    const int nblk = N / 32, kb = item / nblk, nb = item % nblk, k0 = 64 * kb, n0 = 32 * nb;
    float wv[32];
#pragma unroll
    for (int i = 0; i < 32; ++i) wv[i] = W[(size_t)(k0 + 2 * i + (lane >> 5)) * N + n0 + (lane & 31)];
    if (gain) {
#pragma unroll
        for (int i = 0; i < 32; ++i) wv[i] *= gain[k0 + 2 * i + (lane >> 5)];
    }
#pragma unroll
    for (int i = 0; i < 32; ++i) scr[(2 * i + (lane >> 5)) * 33 + (lane & 31)] = wv[i];
    LDS_WAIT(); asm volatile("" ::: "memory");
    int orow0 = n0;
    if (mode == 1) { const int j = n0 < FF ? n0 : n0 - FF; orow0 = (j >> 7) * 256 + (n0 < FF ? 0 : 128) + (j & 127); }
    const int c = lane & 7;
#pragma unroll
    for (int j = 0; j < 4; ++j) { const int n = (lane >> 3) + 8 * j; const LAS float* s = scr + (8 * c) * 33 + n;
        v4u o; o.x = pk2(s[0 * 33], s[1 * 33]); o.y = pk2(s[2 * 33], s[3 * 33]); o.z = pk2(s[4 * 33], s[5 * 33]); o.w = pk2(s[6 * 33], s[7 * 33]);
        *(GAS v4u*)(WT + (size_t)(orow0 + n) * K + k0 + 8 * c) = o; }
    LDS_WAIT(); asm volatile("" ::: "memory");
}

__global__ void __launch_bounds__(NWAVES * 64, 2) layer_fwd(Args args) {
    extern __shared__ __attribute__((aligned(16))) unsigned char lds_raw[];
    LAS unsigned char* lds = (LAS unsigned char*)lds_raw;
    volatile LAS unsigned* MISC = (volatile LAS unsigned*)(lds + MISC_OFF);
    const int tid = threadIdx.x, lane = tid & 63, wave = __builtin_amdgcn_readfirstlane(tid >> 6);
    const int G = gridDim.x, bx = blockIdx.x;
    const int vcu = (G % 8 == 0) ? (bx % 8) * (G / 8) + bx / 8 : bx;
    unsigned char* ws = args.ws;
    gu32* ctl = (gu32*)(ws + WS_CTL);
    float* ss0 = (float*)(ws + WS_SS); float* ss1 = ss0 + M; float* ss2 = ss1 + M; float* ss3 = ss2 + M;
    bf16* Wgu1 = (bf16*)(ws + WS_WGU1); bf16* Wd1 = (bf16*)(ws + WS_WD1); bf16* Win = (bf16*)(ws + WS_WIN); bf16* Wout = (bf16*)(ws + WS_WOUT);
    bf16* Wq = (bf16*)(ws + WS_WQ); bf16* Wkv = (bf16*)(ws + WS_WKV); bf16* Wo = (bf16*)(ws + WS_WO); bf16* Wgu2 = (bf16*)(ws + WS_WGU2); bf16* Wd2 = (bf16*)(ws + WS_WD2);
    bf16* MN = (bf16*)(ws + WS_MN); bf16* KVM = (bf16*)(ws + WS_KVM); bf16* WQK = (bf16*)(ws + WS_WQK); bf16* VWO = (bf16*)(ws + WS_VWO);
    bf16* XB = (bf16*)(ws + WS_XB); bf16* HMID = (bf16*)(ws + WS_HMID);
    bf16* HQ = (bf16*)(ws + WS_HQ); float* LOGF = (float*)(ws + WS_LOGF); bf16* HI = (bf16*)(ws + WS_HI); bf16* HSG = (bf16*)(ws + WS_HSG);
    bf16* SBQ = (bf16*)(ws + WS_SBQ); bf16* SBK = (bf16*)(ws + WS_SBK); bf16* SBV = (bf16*)(ws + WS_SBV);
    bf16* MIXED = (bf16*)(ws + WS_MIXED); bf16* STb = (bf16*)args.out;     float* DVEC = (float*)(ws + WS_DVEC); bf16* PMb = (bf16*)(ws + WS_PM);
    const float* x_in = args.in[0]; float* out = args.out;

    for (int u = tid; u < (LDS_BYTES - LDSCTL_OFF) / 4; u += NWAVES * 64) ((LAS unsigned*)(lds + LDSCTL_OFF))[u] = 0u;
    __syncthreads();
#if MK_ONE_LAUNCH
    XcdBarrier bar = xcd_barrier_post((unsigned*)(ctl + CW_BAR), MISC + 8);
#define GRID_BAR() xcd_barrier(bar)
#else
#define GRID_BAR() do { } while (0)
#endif
    const int lo = args.ph_lo, hi = args.ph_hi;
#define IN(k) (lo <= (k) && (k) < hi)
#ifdef PROBE_PHASE
    unsigned long long* stampw = (unsigned long long*)(ws + WS_CTL + 65536);
#define STAMP(k) do { if (bx == 0 && tid == 0) stampw[(k) + 1] = __builtin_amdgcn_s_memrealtime(); } while (0)
    if (bx == 0 && tid == 0) stampw[0] = __builtin_amdgcn_s_memrealtime();
#else
#define STAMP(k) do { } while (0)
#endif
#define SEAM(k) do { if (IN(k) && IN((k) + 1)) GRID_BAR(); STAMP(k); } while (0)
#define PROBE_T(i) do { } while (0)
    const int gw = vcu * NWAVES + wave, NGW = G * NWAVES;

    if (IN(0)) {
        LAS float* scr = (LAS float*)(lds + wave * 16384);
        constexpr int I_GU = (D / 64) * (GU / 32), I_DN = (FF / 64) * (D / 32), I_IN = (D / 64) * (INC / 32), I_SQ = (D / 64) * (D / 32), I_KV = (D / 64) * (2 * D / 32);
        constexpr int NITEMS = 2 * I_GU + 2 * I_DN + I_IN + 2 * I_SQ + I_KV;
        for (int it = gw; it < NITEMS; it += NGW) {
            int r = it;
            if (r < I_GU) { transpose_item(args.in[3], D, GU, Wgu1, args.in[2], 1, scr, r, lane); continue; } r -= I_GU;
            if (r < I_GU) { transpose_item(args.in[17], D, GU, Wgu2, args.in[16], 1, scr, r, lane); continue; } r -= I_GU;
            if (r < I_DN) { transpose_item(args.in[4], FF, D, Wd1, nullptr, 0, scr, r, lane); continue; } r -= I_DN;
            if (r < I_DN) { transpose_item(args.in[18], FF, D, Wd2, nullptr, 0, scr, r, lane); continue; } r -= I_DN;
            if (r < I_IN) { transpose_item(args.in[6], D, INC, Win, args.in[5], 0, scr, r, lane); continue; } r -= I_IN;
            if (r < I_SQ) { transpose_item(args.in[10], D, D, Wout, nullptr, 0, scr, r, lane); continue; } r -= I_SQ;
            if (r < I_SQ) { transpose_item(args.in[15], D, D, Wo, nullptr, 0, scr, r, lane); continue; } r -= I_SQ;
            transpose_item(args.in[14], D, 2 * D, Wkv, nullptr, 0, scr, r, lane);
        }
        for (int m = gw; m < M; m += 2 * NGW) {
            const GAS f32x4* xr0 = (const GAS f32x4*)(x_in + (size_t)m * D) + lane; const GAS f32x4* xr1 = (const GAS f32x4*)(x_in + (size_t)(m + NGW) * D) + lane; f32x4 v[4], w[4]; float s = 0.f, s1 = 0.f;
#pragma unroll
            for (int j = 0; j < 4; ++j) { v[j] = xr0[64 * j]; w[j] = xr1[64 * j]; }
#pragma unroll
            for (int j = 0; j < 4; ++j) { s += (v[j].x * v[j].x + v[j].y * v[j].y) + (v[j].z * v[j].z + v[j].w * v[j].w); s1 += (w[j].x * w[j].x + w[j].y * w[j].y) + (w[j].z * w[j].z + w[j].w * w[j].w); }
            GAS unsigned long long* o8 = (GAS unsigned long long*)(XB + (size_t)m * D) + lane; GAS unsigned long long* p8 = (GAS unsigned long long*)(XB + (size_t)(m + NGW) * D) + lane;
#pragma unroll
            for (int j = 0; j < 4; ++j) { o8[64 * j] = (unsigned long long)pk2(v[j].x, v[j].y) | ((unsigned long long)pk2(v[j].z, v[j].w) << 32); p8[64 * j] = (unsigned long long)pk2(w[j].x, w[j].y) | ((unsigned long long)pk2(w[j].z, w[j].w) << 32); }
            s = wave_sum(s); s1 = wave_sum(s1);
            if (lane == 0) { ss0[m] = s; ss0[m + NGW] = s1; }
        }
        for (int m = gw; m < D; m += NGW) {
            const GAS f32x4* xr = (const GAS f32x4*)(args.in[13] + (size_t)m * D) + lane; const float g = args.in[11][m];
            GAS unsigned long long* o8 = (GAS unsigned long long*)(Wq + (size_t)m * D) + lane;
#pragma unroll
            for (int j = 0; j < 4; ++j) { const f32x4 v = xr[64 * j] * g; o8[64 * j] = (unsigned long long)pk2(v.x, v.y) | ((unsigned long long)pk2(v.z, v.w) << 32); }
        }
        for (int m = gw; m < MROWS; m += NGW) {
            const GAS f32x4* xr = (const GAS f32x4*)(args.in[1] + (size_t)m * D) + lane; const GAS f32x4* gr = (const GAS f32x4*)(args.in[12]) + lane; f32x4 v[4]; float s = 0.f;
#pragma unroll
            for (int j = 0; j < 4; ++j) { v[j] = xr[64 * j]; s += (v[j].x * v[j].x + v[j].y * v[j].y) + (v[j].z * v[j].z + v[j].w * v[j].w); }
            const float r = __builtin_amdgcn_rsqf(wave_sum(s) * (1.0f / (float)D) + EPS);
            GAS unsigned long long* o8 = (GAS unsigned long long*)(MN + (size_t)m * D) + lane;
#pragma unroll
            for (int j = 0; j < 4; ++j) { const f32x4 g = gr[64 * j]; o8[64 * j] = (unsigned long long)pk2(v[j].x * r * g.x, v[j].y * r * g.y) | ((unsigned long long)pk2(v[j].z * r * g.z, v[j].w * r * g.w) << 32); }
        }
    }
    SEAM(0);
    if (IN(1)) { pg8::TileOrder S; S.init(XB, Wgu1, D, D, M, GU, G, bx); EpiSwiglu E{HMID, ss0}; pg8::gemm_phase(lds, D, D, D, S, E); }
    SEAM(1);
    if (IN(2)) { pg8::TileOrder S; S.init(HMID, Wd1, FF, FF, M, D, G, bx); EpiResid<true> E{x_in, nullptr, XB, ss1, 0.5f}; pg8::gemm_phase(lds, FF, FF, FF, S, E); }
    SEAM(2);
    if (IN(3)) { pg8::TileOrder S; S.init(XB, Win, D, D, M, INC, G, bx); EpiWin E{ss1, args.in[7], HQ, LOGF, HI, HSG, SBQ, SBK, SBV}; pg8::gemm_phase(lds, D, D, D, S, E); }
    SEAM(3);
    if (IN(4)) {
        if (bx < 32) { OneUnit S{(const char*)(MN + (size_t)(bx >> 3) * 256 * D), (const char*)(Wkv + (size_t)(bx & 7) * 256 * D), bx >> 3, bx & 7, 0};
            EpiPlain E{KVM, 2 * D, nullptr, 1.0f, 0}; pg8::gemm_phase(lds, D, D, D, S, E); }
        PROBE_T(0);
        for (int it = bx; it < BATCH * HGH * (SEQ / 64); it += G) hg_pass1(LOGF, HI, STb, DVEC, it, lds, tid, wave, lane);
        PROBE_T(1);
        for (;;) {
            if (tid == 0) MISC[16] = __hip_atomic_fetch_add(ctl + CW_SBQ, 1u, RLX_AGENT);
            __syncthreads();
            const int T = (int)MISC[16];
            __syncthreads();
            if (T >= BATCH * SBH * (SEQ / 256)) break;
            sb_qblock(SBQ, SBK, SBV, args.in[9], MIXED, T >> 5, (T & 31) * 8 + wave, lds + wave * 4096, lane);
        }
        PROBE_T(2);
    }
    SEAM(4);
    if (IN(5)) {
        if (bx >= 128 && bx < 192) {
            const int j = bx - 128, b = j >> 4, h = (j >> 2) & 3, nt = j & 3; int kc = CHD; asm volatile("" : "+s"(kc));
            OneUnit S{(const char*)(KVM + (size_t)b * 256 * (2 * D) + h * CHD), (const char*)(Wq + (size_t)nt * 256 * D + h * CHD), b * 4 + h, nt, 0};
            EpiPlain E{WQK, D, nullptr, CA_QSCALE, 0}; pg8::gemm_phase(lds, kc, 2 * D, D, S, E);
        } else if (bx >= 192) {
            const int j = bx - 192, b = j >> 4, h = (j >> 2) & 3, mt = j & 3; int kc = CHD; asm volatile("" : "+s"(kc));
            OneUnit S{(const char*)(Wo + (size_t)mt * 256 * D + h * CHD), (const char*)(KVM + (size_t)b * 256 * (2 * D) + D + h * CHD), mt, h, b};
            EpiPlain E{VWO, D, nullptr, 1.0f, (size_t)D * D}; pg8::gemm_phase(lds, kc, D, 2 * D, S, E);
        } else if (bx < 128) {
            const int gid = bx * 512 + tid;
            if (gid < BATCH * HGH * HGD * HGD / 4) {
                const int bh = gid >> 12, e = (gid & 4095) * 4, dk = e & 127;
                bf16* sp = STb + (size_t)bh * 128 * (HGD * HGD) + e; const float* dp = DVEC + (size_t)bh * 128 * HGD + dk;
                f32x4 Sv = {0.f, 0.f, 0.f, 0.f};
                for (int c0 = 0; c0 < 128; c0 += 8) {
                    u32x2 u[8]; f32x4 dd[8];
#pragma unroll
                    for (int j = 0; j < 8; ++j) { u[j] = *(const u32x2*)(sp + (size_t)(c0 + j) * (HGD * HGD)); dd[j] = *(const f32x4*)(dp + (size_t)(c0 + j) * HGD); }
#pragma unroll
                    for (int j = 0; j < 8; ++j) { u32x2 o; o.x = cvtpk(Sv[0], Sv[1]); o.y = cvtpk(Sv[2], Sv[3]); *(u32x2*)(sp + (size_t)(c0 + j) * (HGD * HGD)) = o;
                        Sv[0] = dd[j][0] * Sv[0] + bf_lo(u[j].x); Sv[1] = dd[j][1] * Sv[1] + bf_hi(u[j].x); Sv[2] = dd[j][2] * Sv[2] + bf_lo(u[j].y); Sv[3] = dd[j][3] * Sv[3] + bf_hi(u[j].y); }
                }
            }
        }
    }
    SEAM(5);
    if (IN(6)) { for (int it = bx; it < BATCH * HGH * (SEQ / 64); it += G) hg_pass3(LOGF, HQ, HI, HSG, STb, args.in[8], MIXED, it, lds, tid, wave, lane); }
    SEAM(6);
    if (IN(7)) { pg8::TileOrder S; S.init(MIXED, Wout, D, D, M, D, G, bx); EpiResid<false> E{XB, nullptr, XB, ss2, 1.0f}; pg8::gemm_phase(lds, D, D, D, S, E); }
    SEAM(7);
    if (IN(8)) { CrossOrder S{(const char*)XB, (const char*)WQK, G, bx}; EpiSoftmax E{PMb, lds + EPI_OFF, ss2}; pg8::gemm_phase(lds, D, D, D, S, E); }
    SEAM(8);
    if (IN(9)) { CrossOrder S{(const char*)PMb, (const char*)VWO, G, bx}; EpiResid<false> E{XB, nullptr, XB, ss3, 1.0f}; pg8::gemm_phase(lds, D, D, D, S, E); }
    SEAM(9);
    if (IN(10)) { pg8::TileOrder S; S.init(XB, Wgu2, D, D, M, GU, G, bx); EpiSwiglu E{HMID, ss3}; pg8::gemm_phase(lds, D, D, D, S, E); }
    SEAM(10);
    if (IN(11)) { pg8::TileOrder S; S.init(HMID, Wd2, FF, FF, M, D, G, bx); EpiResid<false> E{XB, out, nullptr, nullptr, 0.5f}; pg8::gemm_phase(lds, FF, FF, FF, S, E); }
    SEAM(11);
    if (IN(12)) {
        const GAS f32x4* gr = (const GAS f32x4*)(args.in[19]) + lane;
        for (int m = gw; m < M; m += NGW) {
            GAS f32x4* xr = (GAS f32x4*)(out + (size_t)m * D) + lane; f32x4 v[4]; float s = 0.f;
#pragma unroll
            for (int j = 0; j < 4; ++j) { v[j] = xr[64 * j]; s += (v[j].x * v[j].x + v[j].y * v[j].y) + (v[j].z * v[j].z + v[j].w * v[j].w); }
            const float r = __builtin_amdgcn_rsqf(wave_sum(s) * (1.0f / (float)D) + EPS);
#pragma unroll
            for (int j = 0; j < 4; ++j) { const f32x4 g = gr[64 * j]; xr[64 * j] = v[j] * r * g; }
        }
    }
#ifdef PROBE_PHASE
    if (bx == 0) { VM_WAIT(); __syncthreads(); if (tid == 0) { stampw[13] = __builtin_amdgcn_s_memrealtime();
        const unsigned long long dt = (PROBE_PHASE >= 90) ? stampw[13] - stampw[0] : stampw[PROBE_PHASE + 1] - stampw[PROBE_PHASE];
        out[0] += (float)dt * 0.01f * (PROBE_PHASE >= 90 ? 0.002f : 0.01f); } }
#endif
#undef IN
#undef SEAM
}

constexpr int N_PHASES = 13;
extern "C" void kernel_launch(void* const* d_in, const int* in_sizes, int n_in, void* d_out, int out_size, void* d_ws, size_t ws_size, hipStream_t stream) {
    static int grid = 0;
    if (grid == 0) {
        if (n_in != 20 || in_sizes[0] != M * D || out_size != M * D || ws_size < WS_END) { fprintf(stderr, "kernel_launch: unexpected shapes (n_in %d, in0 %d, out %d, ws %zu)\n", n_in, n_in > 0 ? in_sizes[0] : -1, out_size, ws_size); grid = -1; return; }
        int dev = 0, cus = 0;
        if (hipGetDevice(&dev) != hipSuccess || hipDeviceGetAttribute(&cus, hipDeviceAttributeMultiprocessorCount, dev) != hipSuccess) { grid = -1; return; }
        if (hipFuncSetAttribute((const void*)layer_fwd, hipFuncAttributeMaxDynamicSharedMemorySize, LDS_BYTES) != hipSuccess) { fprintf(stderr, "kernel_launch: hipFuncSetAttribute failed\n"); grid = -1; return; }
        int per_cu = 0;
        if (hipOccupancyMaxActiveBlocksPerMultiprocessor(&per_cu, (const void*)layer_fwd, NWAVES * 64, LDS_BYTES) != hipSuccess || per_cu < 1) fprintf(stderr, "kernel_launch: occupancy query says %d\n", per_cu);
        (void)hipGetLastError();
        grid = cus;
    }
    if (grid < 0) return;
    if (hipMemsetAsync((char*)d_ws + WS_CTL, 0, CTL_ZERO_BYTES, stream) != hipSuccess) return;
    Args a{};
    for (int i = 0; i < 20; ++i) a.in[i] = (const float*)d_in[i];
    a.out = (float*)d_out; a.ws = (unsigned char*)d_ws;
#if MK_ONE_LAUNCH
    a.ph_lo = 0; a.ph_hi = N_PHASES;
    hipLaunchKernelGGL(layer_fwd, dim3(grid), dim3(NWAVES * 64), LDS_BYTES, stream, a);
#else
    for (int p = 0; p < N_PHASES; ++p) { a.ph_lo = p; a.ph_hi = p + 1; hipLaunchKernelGGL(layer_fwd, dim3(grid), dim3(NWAVES * 64), LDS_BYTES, stream, a); }
#endif
}
```
